# Optimizing an MI355X kernel written in HIP

```python
import math
import jax, jax.numpy as jnp
from jax import lax
import numpy as np

D_MODEL = 1024
BATCH = 4
SEQ = 4096
DEPTH = 4

HEAD_DIM = 64
NSA_HEADS = 4
NSA_KV_HEADS = 1
CMP_LEN = 32
CMP_STRIDE = 16
CMP_HIDDEN = 128
SEL_BLOCK = 64
SEL_TOP = 16
NSA_WINDOW = 512
MLA_HEADS = 4
MLA_Q_RANK = 256
MLA_KV_RANK = 128
MLA_NOPE = 64
MLA_ROPE = 32
MLA_V = 64
ROPE_THETA = 10000.0
SWA_HEADS = 8
SWA_KV_HEADS = 1
SWA_WINDOW = 128
REL_BUCKETS = 32
REL_MAX_DIST = 512
N_BIAS_HEADS = NSA_HEADS + SWA_HEADS

Q_BLOCK = 128
NORM_EPS = 1e-6
NEG = -1e30
BIG = 1e9

W_A = NSA_HEADS * HEAD_DIM
W_B = MLA_HEADS * MLA_V
W_C = SWA_HEADS * HEAD_DIM
D_MIX = W_A + W_B + W_C

A_Q = NSA_HEADS * HEAD_DIM
A_KV = 6 * NSA_KV_HEADS * HEAD_DIM
A_GATE = 3 * NSA_HEADS
B_CQ = MLA_Q_RANK
B_CKV = MLA_KV_RANK
B_KR = MLA_ROPE
C_Q = SWA_HEADS * HEAD_DIM
C_KV = 2 * SWA_KV_HEADS * HEAD_DIM
IN_SIZES = (A_Q, A_KV, A_GATE, B_CQ, B_CKV, B_KR, C_Q, C_KV, D_MIX)
D_IN = A_Q + A_KV + A_GATE + B_CQ + B_CKV + B_KR + C_Q + C_KV + D_MIX

kernel_name = 'hymba_nsa_mla_swa_sandwich'


def rms_norm(x, g):
    xf = x.astype(jnp.float32)
    y = xf * lax.rsqrt(jnp.mean(xf * xf, axis=-1, keepdims=True) + NORM_EPS)
    return (y * g.astype(jnp.float32)).astype(x.dtype)


def split_cols(h):
    outs, o = [], 0
    for s in IN_SIZES:
        outs.append(h[..., o:o + s])
        o += s
    return outs


def t5_bucket(dist):
    dist = jnp.maximum(dist, 0)
    exact = REL_BUCKETS // 2
    large = exact + (jnp.log(jnp.maximum(dist, 1).astype(jnp.float32) / exact)
                     / math.log(REL_MAX_DIST / exact) * (REL_BUCKETS - exact)).astype(jnp.int32)
    large = jnp.minimum(large, REL_BUCKETS - 1)
    return jnp.where(dist < exact, dist, large)


def rope(x, pos):
    half = x.shape[-1] // 2
    inv = ROPE_THETA ** (-jnp.arange(half, dtype=jnp.float32) / half)
    ang = pos.astype(jnp.float32)[:, None] * inv[None, :]
    cos, sin = jnp.cos(ang)[:, None, :], jnp.sin(ang)[:, None, :]
    x1, x2 = x[..., :half].astype(jnp.float32), x[..., half:].astype(jnp.float32)
    return jnp.concatenate([x1 * cos - x2 * sin, x2 * cos + x1 * sin], axis=-1).astype(x.dtype)


def banded_attention(q, k, v, window, bias_heads, sinks):
    B, T, H, dh = q.shape
    G = k.shape[2]
    hpg = H // G
    nq = T // Q_BLOCK
    nb = window // Q_BLOCK
    K = (nb + 1) * Q_BLOCK
    pad = ((0, 0), (nb * Q_BLOCK, 0), (0, 0), (0, 0))

    def band(t):
        tp = jnp.pad(t, pad).reshape(B, nq + nb, Q_BLOCK, G, dh)
        return jnp.concatenate([tp[:, i:i + nq] for i in range(nb + 1)], axis=2)

    kb, vb = band(k), band(v)
    qb = q.reshape(B, nq, Q_BLOCK, G, hpg, dh)
    logits = jnp.einsum('bnqghd,bnkgd->bnghqk', qb, kb).astype(jnp.float32) * (dh ** -0.5)
    i = jnp.arange(Q_BLOCK)[:, None]
    j = jnp.arange(K)[None, :]
    dist = nb * Q_BLOCK + i - j
    kpos = (jnp.arange(nq)[:, None, None] - nb) * Q_BLOCK + j[None]
    mask = (dist >= 0) & (dist < window) & (kpos >= 0)
    bias = bias_heads[:, t5_bucket(dist)].reshape(G, hpg, Q_BLOCK, K)
    logits = jnp.where(mask[None, :, None, None], logits + bias, NEG)
    if sinks is None:
        p = jax.nn.softmax(logits, axis=-1)
    else:
        s = jnp.broadcast_to(sinks.reshape(G, hpg, 1, 1).astype(jnp.float32), logits.shape[:-1] + (1,))
        p = jax.nn.softmax(jnp.concatenate([logits, s], axis=-1), axis=-1)[..., :-1]
    out = jnp.einsum('bnghqk,bnkgd->bnqghd', p.astype(v.dtype), vb)
    return out.reshape(B, T, H, dh)


def causal_block_attention(q, k, v, scale):
    B, T, H, dk = q.shape
    nq = T // Q_BLOCK
    qb = q.reshape(B, nq, Q_BLOCK, H, dk).transpose(1, 0, 2, 3, 4)
    kpos = jnp.arange(T)

    def one(args):
        qc, n = args
        logits = jnp.einsum('bqhd,bkhd->bhqk', qc, k).astype(jnp.float32) * scale
        qpos = n * Q_BLOCK + jnp.arange(Q_BLOCK)
        mask = kpos[None, :] <= qpos[:, None]
        p = jax.nn.softmax(jnp.where(mask, logits, NEG), axis=-1)
        return jnp.einsum('bhqk,bkhd->bqhd', p.astype(v.dtype), v)

    out = lax.map(one, (qb, jnp.arange(nq)))
    return out.transpose(1, 0, 2, 3, 4).reshape(B, T, H, v.shape[-1])


def nsa_attention(q, kv, gates, cmp_pos, cmp_w1, cmp_w2, bias_heads):
    B, T, H, dh = q.shape
    G = kv.shape[3]
    hpg = H // G
    scale = dh ** -0.5
    k_cmp, v_cmp, k_slc, v_slc, k_win, v_win = [kv[:, :, i] for i in range(6)]
    pos = jnp.arange(T)
    qg = q.reshape(B, T, G, hpg, dh)

    nc = T // CMP_STRIDE - 1

    def compress(t, pe, w1, w2):
        ch = t.reshape(B, T // CMP_STRIDE, CMP_STRIDE, G, dh)
        blk = jnp.concatenate([ch[:, :-1], ch[:, 1:]], axis=2) + pe[:, None, :]
        blk = blk.transpose(0, 1, 3, 2, 4).reshape(B, nc, G, CMP_LEN * dh)
        return jax.nn.silu(blk @ w1) @ w2

    kc = compress(k_cmp, cmp_pos[0], cmp_w1[0], cmp_w2[0])
    vc = compress(v_cmp, cmp_pos[1], cmp_w1[1], cmp_w2[1])
    lc = jnp.einsum('btghd,bcgd->bghtc', qg, kc).astype(jnp.float32) * scale
    cend = jnp.arange(nc) * CMP_STRIDE + CMP_LEN - 1
    dist_c = pos[:, None] - cend[None, :]
    valid_c = dist_c >= 0
    lc = lc + bias_heads[:, t5_bucket(dist_c)].reshape(G, hpg, T, nc)
    p_c = jax.nn.softmax(jnp.where(valid_c, lc, NEG), axis=-1) * valid_c
    o_cmp = jnp.einsum('bghtc,bcgd->btghd', p_c.astype(vc.dtype), vc)

    ns = T // SEL_BLOCK
    n_top = min(SEL_TOP, ns)
    sstart = np.arange(ns) * SEL_BLOCK
    cstart = np.arange(nc) * CMP_STRIDE
    overlap = (np.clip(np.minimum(cstart[:, None] + CMP_LEN, sstart[None, :] + SEL_BLOCK)
                       - np.maximum(cstart[:, None], sstart[None, :]), 0, None) / CMP_STRIDE).astype(np.float32)
    imp = jnp.einsum('bghtc,cs->bgts', p_c, jnp.asarray(overlap))
    blk = jnp.arange(ns)[None, :]
    cur = (pos // SEL_BLOCK)[:, None]
    forced = (blk == 0) | (blk == cur) | (blk == cur - 1)
    imp = jnp.where(forced, BIG, jnp.where(blk <= cur, imp, -BIG))
    _, idx = lax.top_k(imp, n_top)

    ksb = k_slc.reshape(B, ns, SEL_BLOCK, G, dh).transpose(0, 3, 1, 2, 4)
    vsb = v_slc.reshape(B, ns, SEL_BLOCK, G, dh).transpose(0, 3, 1, 2, 4)
    nq = T // Q_BLOCK
    qch = qg.reshape(B, nq, Q_BLOCK, G, hpg, dh).transpose(1, 0, 3, 4, 2, 5)
    ich = idx.reshape(B, G, nq, Q_BLOCK, n_top).transpose(2, 0, 1, 3, 4)
    gather = jax.vmap(jax.vmap(lambda blocks, ids: blocks[ids]))
    tok = jnp.arange(SEL_BLOCK)
    bias_g = bias_heads.reshape(G, hpg, REL_BUCKETS)
    group_bias = jax.vmap(lambda tab, bk: jnp.moveaxis(tab[:, bk], 0, 1), in_axes=(0, 1), out_axes=1)
    nk = n_top * SEL_BLOCK

    def sel_block(args):
        qc, ic, n = args
        kg = gather(ksb, ic).reshape(B, G, Q_BLOCK, nk, dh)
        vg = gather(vsb, ic).reshape(B, G, Q_BLOCK, nk, dh)
        kpos = (ic[..., None] * SEL_BLOCK + tok).reshape(B, G, Q_BLOCK, nk)
        qpos = n * Q_BLOCK + jnp.arange(Q_BLOCK)
        dist = qpos[:, None] - kpos
        l = jnp.einsum('bghqd,bgqkd->bghqk', qc, kg).astype(jnp.float32) * scale
        l = l + group_bias(bias_g, t5_bucket(dist))
        p = jax.nn.softmax(jnp.where((dist >= 0)[:, :, None], l, NEG), axis=-1)
        return jnp.einsum('bghqk,bgqkd->bqghd', p.astype(vg.dtype), vg)

    o_slc = lax.map(sel_block, (qch, ich, jnp.arange(nq)))
    o_slc = o_slc.transpose(1, 0, 2, 3, 4, 5).reshape(B, T, H, dh)

    o_win = banded_attention(q, k_win, v_win, NSA_WINDOW, bias_heads, None)

    g = jax.nn.sigmoid(gates.astype(jnp.float32)).astype(q.dtype)
    o = (g[..., 0:1] * o_cmp.reshape(B, T, H, dh) + g[..., 1:2] * o_slc + g[..., 2:3] * o_win)
    return o.reshape(B, T, H * dh)


def hybrid_layer(x, w_in, w_out, g_pre, g_post, cmp_pos, cmp_w1, cmp_w2,
                 q_norm, w_uq, kv_norm, w_ukv, sinks, rel_bias):
    B, T, _ = x.shape
    pos = jnp.arange(T)
    h = rms_norm(x, g_pre)
    a_q, a_kv, a_g, b_cq, b_ckv, b_kr, c_q, c_kv, z = split_cols(h @ w_in)

    o_a = nsa_attention(a_q.reshape(B, T, NSA_HEADS, HEAD_DIM),
                        a_kv.reshape(B, T, 6, NSA_KV_HEADS, HEAD_DIM),
                        a_g.reshape(B, T, NSA_HEADS, 3),
                        cmp_pos, cmp_w1, cmp_w2, rel_bias[:NSA_HEADS])

    qb = (rms_norm(b_cq, q_norm) @ w_uq).reshape(B, T, MLA_HEADS, MLA_NOPE + MLA_ROPE)
    q_full = jnp.concatenate([qb[..., :MLA_NOPE], rope(qb[..., MLA_NOPE:], pos)], axis=-1)
    kvb = (rms_norm(b_ckv, kv_norm) @ w_ukv).reshape(B, T, MLA_HEADS, MLA_NOPE + MLA_V)
    k_rope = rope(b_kr.reshape(B, T, 1, MLA_ROPE), pos)
    k_full = jnp.concatenate([kvb[..., :MLA_NOPE],
                              jnp.broadcast_to(k_rope, (B, T, MLA_HEADS, MLA_ROPE))], axis=-1)
    o_b = causal_block_attention(q_full, k_full, kvb[..., MLA_NOPE:], (MLA_NOPE + MLA_ROPE) ** -0.5)

    ckv = c_kv.reshape(B, T, 2, SWA_KV_HEADS, HEAD_DIM)
    o_c = banded_attention(c_q.reshape(B, T, SWA_HEADS, HEAD_DIM), ckv[:, :, 0], ckv[:, :, 1],
                           SWA_WINDOW, rel_bias[NSA_HEADS:], sinks)

    mixed = jnp.concatenate([o_a, o_b.reshape(B, T, W_B), o_c.reshape(B, T, W_C)], axis=-1) * jax.nn.silu(z)
    return x + rms_norm(mixed @ w_out, g_post)


def setup_inputs(seed: int = 0) -> dict:
    key = jax.random.key(seed)
    ks = jax.random.split(key, 14)
    f32 = jnp.float32

    def nrm(k, shape, scale):
        return jax.random.normal(k, shape, f32) * scale

    return {
        'x': nrm(ks[0], (BATCH, SEQ, D_MODEL), 1.0),
        'w_in': nrm(ks[1], (DEPTH, D_MODEL, D_IN), D_MODEL ** -0.5),
        'w_out': nrm(ks[2], (DEPTH, D_MIX, D_MODEL), D_MIX ** -0.5),
        'norm_pre': 1.0 + nrm(ks[3], (DEPTH, D_MODEL), 0.05),
        'norm_post': 1.0 + nrm(ks[4], (DEPTH, D_MODEL), 0.05),
        'cmp_pos': nrm(ks[5], (DEPTH, 2, CMP_LEN, HEAD_DIM), 0.1),
        'cmp_w1': nrm(ks[6], (DEPTH, 2, CMP_LEN * HEAD_DIM, CMP_HIDDEN), (CMP_LEN * HEAD_DIM) ** -0.5),
        'cmp_w2': nrm(ks[7], (DEPTH, 2, CMP_HIDDEN, HEAD_DIM), CMP_HIDDEN ** -0.5),
        'mla_q_norm': 1.0 + nrm(ks[8], (DEPTH, MLA_Q_RANK), 0.05),
        'mla_w_uq': nrm(ks[9], (DEPTH, MLA_Q_RANK, MLA_HEADS * (MLA_NOPE + MLA_ROPE)), MLA_Q_RANK ** -0.5),
        'mla_kv_norm': 1.0 + nrm(ks[10], (DEPTH, MLA_KV_RANK), 0.05),
        'mla_w_ukv': nrm(ks[11], (DEPTH, MLA_KV_RANK, MLA_HEADS * (MLA_NOPE + MLA_V)), MLA_KV_RANK ** -0.5),
        'swa_sinks': nrm(ks[12], (DEPTH, SWA_HEADS), 0.5),
        'rel_bias': nrm(ks[13], (N_BIAS_HEADS, REL_BUCKETS), 0.5),
    }


def reference(x, w_in, w_out, norm_pre, norm_post, cmp_pos, cmp_w1, cmp_w2,
              mla_q_norm, mla_w_uq, mla_kv_norm, mla_w_ukv, swa_sinks, rel_bias):
    for l in range(DEPTH):
        x = hybrid_layer(x, w_in[l], w_out[l], norm_pre[l], norm_post[l],
                         cmp_pos[l], cmp_w1[l], cmp_w2[l],
                         mla_q_norm[l], mla_w_uq[l], mla_kv_norm[l], mla_w_ukv[l],
                         swa_sinks[l], rel_bias)
    return x
```

```cpp
#include <hip/hip_runtime.h>
#include <stdint.h>

typedef unsigned short bf16_t;
#define DI __device__ __forceinline__

DI float bf2f(bf16_t v) { return __uint_as_float(((unsigned)v) << 16); }
DI bf16_t f2bf(float f) { unsigned u = __float_as_uint(f); u += 0x7fffu + ((u >> 16) & 1u); return (bf16_t)(u >> 16); }
DI float bflo(unsigned w) { return __uint_as_float(w << 16); }
DI float bfhi(unsigned w) { return __uint_as_float(w & 0xffff0000u); }

constexpr int NB = 4, T = 4096, D = 1024, NTOK = NB * T, DEPTH = 4, DIN = 2732, NP = 2816;
constexpr int C_AQ = 0, C_KCMP = 256, C_VCMP = 320, C_KSLC = 384, C_VSLC = 448, C_KWIN = 512, C_VWIN = 576;
constexpr int C_BCQ = 640, C_BCKV = 896, C_CQ = 1024, C_CK = 1536, C_CV = 1600, C_Z = 1664, C_BKR = 2688, C_AG = 2720;
constexpr int BT_STRIDE = 520;

__host__ __device__ inline int src_col(int n) {
    if (n < 640) return n;
    if (n < 896) return 652 + (n - 640);
    if (n < 1024) return 908 + (n - 896);
    if (n < 1536) return 1068 + (n - 1024);
    if (n < 1664) return 1580 + (n - 1536);
    if (n < 2688) return 1708 + (n - 1664);
    if (n < 2720) return 1036 + (n - 2688);
    if (n < 2732) return 640 + (n - 2720);
    return -1;
}

DI int t5_bucket(int d) {
    if (d < 16) return d < 0 ? 0 : d;
    int b = 16;
    b += d >= 20; b += d >= 25; b += d >= 31; b += d >= 39; b += d >= 48; b += d >= 59; b += d >= 73; b += d >= 91;
    b += d >= 113; b += d >= 140; b += d >= 174; b += d >= 216; b += d >= 268; b += d >= 332; b += d >= 413;
    return b;
}

struct Params {
    const float* x_in; const float* w_in; const float* w_out; const float* norm_pre; const float* norm_post;
    const float* cmp_pos; const float* cmp_w1; const float* cmp_w2; const float* q_norm; const float* w_uq;
    const float* kv_norm; const float* w_ukv; const float* sinks; const float* rel_bias;
    float* xout;
    bf16_t* P;
    float* y;
    bf16_t* Qm;
    bf16_t* Km;
    bf16_t* Vm;
    bf16_t* mixed;
    float* oa;
    float* rs;
    float* kc;
    float* vc;
    unsigned long long* selmask;
    float* btab;
};

__global__ void k_btab(Params p) {
    int i = blockIdx.x * blockDim.x + threadIdx.x;
    if (i < 12 * BT_STRIDE) { int h = i / BT_STRIDE, d = i % BT_STRIDE; p.btab[i] = p.rel_bias[h * 32 + t5_bucket(d)]; }
}

__global__ void __launch_bounds__(256) k_rowscale(const float* x, float* rs) {
    int row = blockIdx.x * 4 + (threadIdx.x >> 6), lane = threadIdx.x & 63;
    const float4* xp = (const float4*)(x + (size_t)row * D);
    float s = 0.f;
    for (int i = lane; i < D / 4; i += 64) { float4 v = xp[i]; s += v.x * v.x + v.y * v.y + v.z * v.z + v.w * v.w; }
    for (int o = 32; o > 0; o >>= 1) s += __shfl_xor(s, o);
    if (lane == 0) rs[row] = rsqrtf(s * (1.0f / D) + 1e-6f);
}

template <int MODE>
__global__ void __launch_bounds__(256) k_gemm(Params p, int layer) {
    __shared__ float As[8][128 + 4];
    __shared__ float Bs[8][128 + 4];
    const int tid = threadIdx.x, tx = tid & 15, ty = tid >> 4;
    const int m0 = blockIdx.y * 128, n0 = blockIdx.x * 128;
    const float* x = (layer == 0) ? p.x_in : p.xout;
    const float* W = MODE == 0 ? p.w_in + (size_t)layer * D * DIN : p.w_out + (size_t)layer * D * D;
    const float* g = p.norm_pre + layer * D;
    float acc[8][8];
#pragma unroll
    for (int i = 0; i < 8; ++i)
#pragma unroll
        for (int j = 0; j < 8; ++j) acc[i][j] = 0.f;
    const int arow = tid >> 1, ak4 = (tid & 1) * 4;
    const int bk = tid >> 5, bn4 = (tid & 31) * 4;
    int bsrc = 0;
    if (MODE == 0) bsrc = src_col(n0 + bn4); else bsrc = n0 + bn4;
    for (int k0 = 0; k0 < D; k0 += 8) {
        float4 av;
        if (MODE == 0) av = *(const float4*)(x + (size_t)(m0 + arow) * D + k0 + ak4);
        else { const uint2 w = *(const uint2*)(p.mixed + (size_t)(m0 + arow) * D + k0 + ak4); av = make_float4(bflo(w.x), bfhi(w.x), bflo(w.y), bfhi(w.y)); }
        float4 bv = make_float4(0.f, 0.f, 0.f, 0.f);
        if (bsrc >= 0) {
            bv = *(const float4*)(W + (size_t)(k0 + bk) * (MODE == 0 ? DIN : D) + bsrc);
            if (MODE == 0) { const float gg = g[k0 + bk]; bv.x *= gg; bv.y *= gg; bv.z *= gg; bv.w *= gg; }
        }
        __syncthreads();
        As[ak4 + 0][arow] = av.x; As[ak4 + 1][arow] = av.y; As[ak4 + 2][arow] = av.z; As[ak4 + 3][arow] = av.w;
        *(float4*)&Bs[bk][bn4] = bv;
        __syncthreads();
#pragma unroll
        for (int kk = 0; kk < 8; ++kk) {
            float a[8], b[8];
            *(float4*)&a[0] = *(const float4*)&As[kk][ty * 4]; *(float4*)&a[4] = *(const float4*)&As[kk][64 + ty * 4];
            *(float4*)&b[0] = *(const float4*)&Bs[kk][tx * 4]; *(float4*)&b[4] = *(const float4*)&Bs[kk][64 + tx * 4];
#pragma unroll
            for (int i = 0; i < 8; ++i)
#pragma unroll
                for (int j = 0; j < 8; ++j) acc[i][j] += a[i] * b[j];
        }
    }
#pragma unroll
    for (int i = 0; i < 8; ++i) {
        const int row = m0 + (i < 4 ? ty * 4 + i : 64 + ty * 4 + (i - 4));
        if (MODE == 0) {
            const float r = p.rs[row];
#pragma unroll
            for (int jj = 0; jj < 2; ++jj) {
                const int col = n0 + jj * 64 + tx * 4;
                uint2 w; w.x = (unsigned)f2bf(acc[i][jj * 4 + 0] * r) | ((unsigned)f2bf(acc[i][jj * 4 + 1] * r) << 16);
                w.y = (unsigned)f2bf(acc[i][jj * 4 + 2] * r) | ((unsigned)f2bf(acc[i][jj * 4 + 3] * r) << 16);
                *(uint2*)(p.P + (size_t)row * NP + col) = w;
            }
        } else {
#pragma unroll
            for (int jj = 0; jj < 2; ++jj) {
                const int col = n0 + jj * 64 + tx * 4;
                *(float4*)(p.y + (size_t)row * D + col) = make_float4(acc[i][jj * 4 + 0], acc[i][jj * 4 + 1], acc[i][jj * 4 + 2], acc[i][jj * 4 + 3]);
            }
        }
    }
}

__global__ void __launch_bounds__(256) k_mla_up(Params p, int layer) {
    __shared__ float cq[8][256];
    __shared__ float ckv[8][128];
    __shared__ float qb[8][384];
    __shared__ float red[8][2];
    const int tid = threadIdx.x, tok0 = blockIdx.x * 8;
    {
        const int tk = tid >> 5, l32 = tid & 31;
        float s1 = 0.f, s2 = 0.f;
        for (int k = l32; k < 256; k += 32) { float v = bf2f(p.P[(size_t)(tok0 + tk) * NP + C_BCQ + k]); cq[tk][k] = v; s1 += v * v; }
        for (int k = l32; k < 128; k += 32) { float v = bf2f(p.P[(size_t)(tok0 + tk) * NP + C_BCKV + k]); ckv[tk][k] = v; s2 += v * v; }
        for (int o = 16; o > 0; o >>= 1) { s1 += __shfl_xor(s1, o); s2 += __shfl_xor(s2, o); }
        if (l32 == 0) { red[tk][0] = rsqrtf(s1 * (1.f / 256.f) + 1e-6f); red[tk][1] = rsqrtf(s2 * (1.f / 128.f) + 1e-6f); }
    }
    __syncthreads();
    {
        const int tk = tid >> 5, l32 = tid & 31;
        for (int k = l32; k < 256; k += 32) cq[tk][k] *= red[tk][0] * p.q_norm[layer * 256 + k];
        for (int k = l32; k < 128; k += 32) ckv[tk][k] *= red[tk][1] * p.kv_norm[layer * 128 + k];
    }
    __syncthreads();
    const float* wq = p.w_uq + (size_t)layer * 256 * 384;
    for (int j = tid; j < 384; j += 256) {
        float acc[8] = {0, 0, 0, 0, 0, 0, 0, 0};
        for (int k = 0; k < 256; ++k) { const float w = wq[k * 384 + j];
#pragma unroll
            for (int tk = 0; tk < 8; ++tk) acc[tk] += cq[tk][k] * w; }
#pragma unroll
        for (int tk = 0; tk < 8; ++tk) qb[tk][j] = acc[tk];
    }
    const float* wkv = p.w_ukv + (size_t)layer * 128 * 512;
    for (int j = tid; j < 512; j += 256) {
        float acc[8] = {0, 0, 0, 0, 0, 0, 0, 0};
        for (int k = 0; k < 128; ++k) { const float w = wkv[k * 512 + j];
#pragma unroll
            for (int tk = 0; tk < 8; ++tk) acc[tk] += ckv[tk][k] * w; }
        const int h = j >> 7, e = j & 127;
#pragma unroll
        for (int tk = 0; tk < 8; ++tk) {
            if (e < 64) p.Km[(size_t)(tok0 + tk) * 384 + h * 96 + e] = f2bf(acc[tk]);
            else p.Vm[(size_t)(tok0 + tk) * 256 + h * 64 + (e - 64)] = f2bf(acc[tk]);
        }
    }
    __syncthreads();
    for (int idx = tid; idx < 8 * 4 * 64; idx += 256) {
        const int tk = idx >> 8, h = (idx >> 6) & 3, e = idx & 63;
        p.Qm[(size_t)(tok0 + tk) * 384 + h * 96 + e] = f2bf(qb[tk][h * 96 + e]);
    }
    for (int idx = tid; idx < 8 * 5 * 16; idx += 256) {
        const int tk = idx / 80, r = idx % 80, h = r >> 4, i = r & 15;
        const int tok = tok0 + tk, pos = tok % T;
        const float inv = powf(10000.0f, -(float)i / 16.0f);
        const float ang = (float)pos * inv;
        const float cs = cosf(ang), sn = sinf(ang);
        if (h < 4) {
            const float x1 = qb[tk][h * 96 + 64 + i], x2 = qb[tk][h * 96 + 80 + i];
            p.Qm[(size_t)tok * 384 + h * 96 + 64 + i] = f2bf(x1 * cs - x2 * sn);
            p.Qm[(size_t)tok * 384 + h * 96 + 80 + i] = f2bf(x2 * cs + x1 * sn);
        } else {
            const float x1 = bf2f(p.P[(size_t)tok * NP + C_BKR + i]), x2 = bf2f(p.P[(size_t)tok * NP + C_BKR + 16 + i]);
            const bf16_t o1 = f2bf(x1 * cs - x2 * sn), o2 = f2bf(x2 * cs + x1 * sn);
            for (int hh = 0; hh < 4; ++hh) { p.Km[(size_t)tok * 384 + hh * 96 + 64 + i] = o1; p.Km[(size_t)tok * 384 + hh * 96 + 80 + i] = o2; }
        }
    }
}

__global__ void __launch_bounds__(256) k_compress(Params p, int layer) {
    __shared__ float tok[144][64];
    __shared__ float pe[32][64];
    __shared__ float hid[8][128];
    const int tid = threadIdx.x, c0 = blockIdx.x * 8, which = blockIdx.y, b = blockIdx.z;
    const int col = which == 0 ? C_KCMP : C_VCMP;
    for (int idx = tid; idx < 144 * 64; idx += 256) {
        const int r = idx >> 6, d = idx & 63, t = c0 * 16 + r;
        tok[r][d] = t < T ? bf2f(p.P[(size_t)(b * T + t) * NP + col + d]) : 0.f;
    }
    const float* pep = p.cmp_pos + ((size_t)layer * 2 + which) * 32 * 64;
    for (int idx = tid; idx < 32 * 64; idx += 256) pe[idx >> 6][idx & 63] = pep[idx];
    __syncthreads();
    const int j = tid & 127, half = tid >> 7;
    const float* w1 = p.cmp_w1 + ((size_t)layer * 2 + which) * 2048 * 128;
    float acc[4] = {0, 0, 0, 0};
    for (int i = 0; i < 32; ++i)
        for (int d = 0; d < 64; ++d) {
            const float w = w1[(size_t)(i * 64 + d) * 128 + j], pp = pe[i][d];
#pragma unroll
            for (int cc = 0; cc < 4; ++cc) acc[cc] += (tok[(half * 4 + cc) * 16 + i][d] + pp) * w;
        }
#pragma unroll
    for (int cc = 0; cc < 4; ++cc) { const float a = acc[cc]; hid[half * 4 + cc][j] = a / (1.f + expf(-a)); }
    __syncthreads();
    const float* w2 = p.cmp_w2 + ((size_t)layer * 2 + which) * 128 * 64;
    float* outp = which == 0 ? p.kc : p.vc;
    for (int idx = tid; idx < 8 * 64; idx += 256) {
        const int cc = idx >> 6, d = idx & 63, c = c0 + cc;
        float s = 0.f;
        for (int jj = 0; jj < 128; ++jj) s += hid[cc][jj] * w2[jj * 64 + d];
        if (c < 255) outp[((size_t)b * 256 + c) * 64 + d] = s;
    }
}

__global__ void __launch_bounds__(256) k_cmp_attn(Params p) {
    __shared__ float imp[64][65];
    const int tid = threadIdx.x, tl = tid >> 2, h = tid & 3;
    const int b = blockIdx.y, t0 = blockIdx.x * 64, t = t0 + tl;
    const size_t tok = (size_t)b * T + t;
    float q[64];
    {
        const uint4* qp = (const uint4*)(p.P + tok * NP + C_AQ + h * 64);
#pragma unroll
        for (int c = 0; c < 8; ++c) { const uint4 w = qp[c];
            q[c * 8 + 0] = bflo(w.x); q[c * 8 + 1] = bfhi(w.x); q[c * 8 + 2] = bflo(w.y); q[c * 8 + 3] = bfhi(w.y);
            q[c * 8 + 4] = bflo(w.z); q[c * 8 + 5] = bfhi(w.z); q[c * 8 + 6] = bflo(w.w); q[c * 8 + 7] = bfhi(w.w); }
    }
    const int nv = t >= 31 ? min(255, (t - 31) / 16 + 1) : 0;
    const int nvmax = (t0 + 63 >= 31) ? min(255, (t0 + 63 - 31) / 16 + 1) : 0;
    const float* kcb = p.kc + (size_t)b * 256 * 64;
    const float* vcb = p.vc + (size_t)b * 256 * 64;
    const float* bt = p.btab + h * BT_STRIDE;
    float m = -1e30f, l = 0.f;
    for (int c = 0; c < nvmax; ++c) {
        const float4* kp = (const float4*)(kcb + c * 64);
        float s = 0.f;
#pragma unroll
        for (int d4 = 0; d4 < 16; ++d4) { const float4 kv = kp[d4]; s += q[d4 * 4] * kv.x + q[d4 * 4 + 1] * kv.y + q[d4 * 4 + 2] * kv.z + q[d4 * 4 + 3] * kv.w; }
        if (c < nv) {
            const int dist = t - (16 * c + 31);
            s = s * 0.125f + bt[min(dist, 512)];
            const float mn = fmaxf(m, s);
            l = l * expf(m - mn) + expf(s - mn); m = mn;
        }
    }
    const float invl = nv > 0 ? 1.f / l : 0.f;
    float o[64];
#pragma unroll
    for (int d = 0; d < 64; ++d) o[d] = 0.f;
    float prev3 = 0.f;
    for (int s4 = 0; s4 < 64; ++s4) {
        float pc[4];
#pragma unroll
        for (int r = 0; r < 4; ++r) {
            const int c = s4 * 4 + r;
            float pr = 0.f;
            if (c < nvmax) {
                const float4* kp = (const float4*)(kcb + c * 64);
                float s = 0.f;
#pragma unroll
                for (int d4 = 0; d4 < 16; ++d4) { const float4 kv = kp[d4]; s += q[d4 * 4] * kv.x + q[d4 * 4 + 1] * kv.y + q[d4 * 4 + 2] * kv.z + q[d4 * 4 + 3] * kv.w; }
                if (c < nv) {
                    const int dist = t - (16 * c + 31);
                    s = s * 0.125f + bt[min(dist, 512)];
                    pr = expf(s - m) * invl;
                    const float4* vp = (const float4*)(vcb + c * 64);
#pragma unroll
                    for (int d4 = 0; d4 < 16; ++d4) { const float4 vv = vp[d4]; o[d4 * 4] += pr * vv.x; o[d4 * 4 + 1] += pr * vv.y; o[d4 * 4 + 2] += pr * vv.z; o[d4 * 4 + 3] += pr * vv.w; }
                }
            }
            pc[r] = pr;
        }
        float v = 2.f * (pc[0] + pc[1] + pc[2]) + pc[3] + prev3;
        prev3 = pc[3];
        v += __shfl_xor(v, 1); v += __shfl_xor(v, 2);
        if (h == 0) imp[tl][s4] = v;
    }
    {
        const float gl = bf2f(p.P[tok * NP + C_AG + h * 3 + 0]);
        const float gt = 1.f / (1.f + expf(-gl));
        float* op = p.oa + tok * 256 + h * 64;
#pragma unroll
        for (int d4 = 0; d4 < 16; ++d4) *(float4*)(op + d4 * 4) = make_float4(gt * o[d4 * 4], gt * o[d4 * 4 + 1], gt * o[d4 * 4 + 2], gt * o[d4 * 4 + 3]);
    }
    __syncthreads();
    if (h == 0) {
        const int cur = t >> 6;
        unsigned long long mask;
        if (cur + 1 <= 16) mask = (cur == 63) ? ~0ull : ((1ull << (cur + 1)) - 1ull);
        else {
            mask = 1ull | (1ull << cur) | (1ull << (cur - 1));
            for (int it = 0; it < 13; ++it) {
                float best = -3e38f; int bi = -1;
                for (int s = 1; s <= cur - 2; ++s) { const float v = imp[tl][s]; if (!((mask >> s) & 1ull) && v > best) { best = v; bi = s; } }
                if (bi >= 0) mask |= 1ull << bi;
            }
        }
        p.selmask[tok] = mask;
    }
}

template <int MODE>
__global__ void __launch_bounds__(256) k_attn(Params p, int layer) {
    constexpr int DK = MODE == 0 ? 96 : 64;
    const int tid = threadIdx.x, tl = tid & 63, hh = tid >> 6;
    const int b = blockIdx.y, t0 = blockIdx.x * 64, t = t0 + tl;
    const int h = (MODE == 2 ? blockIdx.z * 4 : 0) + hh;
    const size_t tok = (size_t)b * T + t;
    const bf16_t *Kb, *Vb, *qp; int kst, vst; float scale; const float* bt = nullptr; int W;
    if (MODE == 0) { Kb = p.Km + (size_t)b * T * 384 + h * 96; Vb = p.Vm + (size_t)b * T * 256 + h * 64; kst = 384; vst = 256; qp = p.Qm + tok * 384 + h * 96; scale = 0.10206207261596577f; W = 1 << 30; }
    if (MODE == 1) { Kb = p.P + (size_t)b * T * NP + C_KWIN; Vb = p.P + (size_t)b * T * NP + C_VWIN; kst = NP; vst = NP; qp = p.P + tok * NP + C_AQ + h * 64; scale = 0.125f; bt = p.btab + h * BT_STRIDE; W = 512; }
    if (MODE == 2) { Kb = p.P + (size_t)b * T * NP + C_CK; Vb = p.P + (size_t)b * T * NP + C_CV; kst = NP; vst = NP; qp = p.P + tok * NP + C_CQ + h * 64; scale = 0.125f; bt = p.btab + (4 + h) * BT_STRIDE; W = 128; }
    if (MODE == 3) { Kb = p.P + (size_t)b * T * NP + C_KSLC; Vb = p.P + (size_t)b * T * NP + C_VSLC; kst = NP; vst = NP; qp = p.P + tok * NP + C_AQ + h * 64; scale = 0.125f; bt = p.btab + h * BT_STRIDE; W = 1 << 30; }
    float q[DK];
#pragma unroll
    for (int c = 0; c < DK / 8; ++c) { const uint4 w = ((const uint4*)qp)[c];
        q[c * 8 + 0] = bflo(w.x); q[c * 8 + 1] = bfhi(w.x); q[c * 8 + 2] = bflo(w.y); q[c * 8 + 3] = bfhi(w.y);
        q[c * 8 + 4] = bflo(w.z); q[c * 8 + 5] = bfhi(w.z); q[c * 8 + 6] = bflo(w.w); q[c * 8 + 7] = bfhi(w.w); }
    float o[64];
#pragma unroll
    for (int d = 0; d < 64; ++d) o[d] = 0.f;
    float m = -1e30f, l = 0.f;
    unsigned long long mask = ~0ull;
    if (MODE == 3) mask = p.selmask[tok];
    const int jlo = (MODE == 1 || MODE == 2) ? max(0, t0 - (W - 1)) : 0;
    const int jhi = t0 + 63;
    for (int j = jlo; j <= jhi; ++j) {
        if (MODE == 3) { if ((j & 63) == 0 && !__any((int)((mask >> (j >> 6)) & 1ull))) { j += 63; continue; } }
        const uint4* kp = (const uint4*)(Kb + (size_t)j * kst);
        float s = 0.f;
#pragma unroll
        for (int c = 0; c < DK / 8; ++c) { const uint4 w = kp[c];
            s += q[c * 8 + 0] * bflo(w.x) + q[c * 8 + 1] * bfhi(w.x) + q[c * 8 + 2] * bflo(w.y) + q[c * 8 + 3] * bfhi(w.y)
               + q[c * 8 + 4] * bflo(w.z) + q[c * 8 + 5] * bfhi(w.z) + q[c * 8 + 6] * bflo(w.w) + q[c * 8 + 7] * bfhi(w.w); }
        const int dist = t - j;
        bool valid = dist >= 0 && dist < W;
        if (MODE == 3) valid = valid && ((mask >> (j >> 6)) & 1ull);
        if (valid) {
            s *= scale;
            if (MODE != 0) s += bt[min(dist, 512)];
            const float mn = fmaxf(m, s), a = expf(m - mn), pr = expf(s - mn);
            l = l * a + pr; m = mn;
            const uint4* vp = (const uint4*)(Vb + (size_t)j * vst);
#pragma unroll
            for (int c = 0; c < 8; ++c) { const uint4 w = vp[c];
                o[c * 8 + 0] = o[c * 8 + 0] * a + pr * bflo(w.x); o[c * 8 + 1] = o[c * 8 + 1] * a + pr * bfhi(w.x);
                o[c * 8 + 2] = o[c * 8 + 2] * a + pr * bflo(w.y); o[c * 8 + 3] = o[c * 8 + 3] * a + pr * bfhi(w.y);
                o[c * 8 + 4] = o[c * 8 + 4] * a + pr * bflo(w.z); o[c * 8 + 5] = o[c * 8 + 5] * a + pr * bfhi(w.z);
                o[c * 8 + 6] = o[c * 8 + 6] * a + pr * bflo(w.w); o[c * 8 + 7] = o[c * 8 + 7] * a + pr * bfhi(w.w); }
        }
    }
    if (MODE == 2) { const float sk = p.sinks[layer * 8 + h]; const float mn = fmaxf(m, sk); const float a = expf(m - mn); l = l * a + expf(sk - mn);
#pragma unroll
        for (int d = 0; d < 64; ++d) o[d] *= a; }
    const float invl = 1.f / l;
    if (MODE == 3) {
        const float gl = bf2f(p.P[tok * NP + C_AG + h * 3 + 1]);
        const float gt = invl / (1.f + expf(-gl));
        float* op = p.oa + tok * 256 + h * 64;
#pragma unroll
        for (int d = 0; d < 64; ++d) op[d] += gt * o[d];
    } else {
        float gt = invl; int mcol;
        if (MODE == 1) { const float gl = bf2f(p.P[tok * NP + C_AG + h * 3 + 2]); gt = invl / (1.f + expf(-gl)); mcol = h * 64; }
        else if (MODE == 0) mcol = 256 + h * 64; else mcol = 512 + h * 64;
        const bf16_t* zp = p.P + tok * NP + C_Z + mcol;
        bf16_t* mp = p.mixed + tok * 1024 + mcol;
        const float* op = p.oa + tok * 256 + h * 64;
#pragma unroll
        for (int d = 0; d < 64; ++d) {
            float v = gt * o[d]; if (MODE == 1) v += op[d];
            const float z = bf2f(zp[d]);
            mp[d] = f2bf(v * z / (1.f + expf(-z)));
        }
    }
}

__global__ void __launch_bounds__(256) k_postnorm(Params p, int layer) {
    const int row = blockIdx.x * 4 + (threadIdx.x >> 6), lane = threadIdx.x & 63;
    const float* x = (layer == 0 ? p.x_in : p.xout) + (size_t)row * D;
    const float* y = p.y + (size_t)row * D;
    const float* g = p.norm_post + layer * D;
    float4 yv[4]; float s = 0.f;
#pragma unroll
    for (int i = 0; i < 4; ++i) { yv[i] = ((const float4*)y)[lane + 64 * i]; s += yv[i].x * yv[i].x + yv[i].y * yv[i].y + yv[i].z * yv[i].z + yv[i].w * yv[i].w; }
    for (int o = 32; o > 0; o >>= 1) s += __shfl_xor(s, o);
    const float r = rsqrtf(s * (1.f / D) + 1e-6f);
    float s2 = 0.f;
#pragma unroll
    for (int i = 0; i < 4; ++i) {
        const float4 xv = ((const float4*)x)[lane + 64 * i], gv = ((const float4*)g)[lane + 64 * i];
        float4 o; o.x = xv.x + yv[i].x * r * gv.x; o.y = xv.y + yv[i].y * r * gv.y; o.z = xv.z + yv[i].z * r * gv.z; o.w = xv.w + yv[i].w * r * gv.w;
        ((float4*)(p.xout + (size_t)row * D))[lane + 64 * i] = o;
        s2 += o.x * o.x + o.y * o.y + o.z * o.z + o.w * o.w;
    }
    for (int o = 32; o > 0; o >>= 1) s2 += __shfl_xor(s2, o);
    if (lane == 0) p.rs[row] = rsqrtf(s2 * (1.f / D) + 1e-6f);
}

extern "C" void kernel_launch(void* const* d_in, const int* in_sizes, int n_in, void* d_out, int out_size, void* d_ws, size_t ws_size, hipStream_t stream) {
    Params p{};
    p.x_in = (const float*)d_in[0]; p.w_in = (const float*)d_in[1]; p.w_out = (const float*)d_in[2]; p.norm_pre = (const float*)d_in[3]; p.norm_post = (const float*)d_in[4];
    p.cmp_pos = (const float*)d_in[5]; p.cmp_w1 = (const float*)d_in[6]; p.cmp_w2 = (const float*)d_in[7]; p.q_norm = (const float*)d_in[8]; p.w_uq = (const float*)d_in[9];
    p.kv_norm = (const float*)d_in[10]; p.w_ukv = (const float*)d_in[11]; p.sinks = (const float*)d_in[12]; p.rel_bias = (const float*)d_in[13];
    p.xout = (float*)d_out;
    char* w = (char*)d_ws; size_t off = 0;
    auto take = [&](size_t bytes) { char* r = w + off; off += (bytes + 255) & ~(size_t)255; return r; };
    p.P = (bf16_t*)take((size_t)NTOK * NP * 2); p.y = (float*)p.P;
    p.Qm = (bf16_t*)take((size_t)NTOK * 384 * 2); p.Km = (bf16_t*)take((size_t)NTOK * 384 * 2); p.Vm = (bf16_t*)take((size_t)NTOK * 256 * 2);
    p.mixed = (bf16_t*)take((size_t)NTOK * 1024 * 2); p.oa = (float*)take((size_t)NTOK * 256 * 4); p.rs = (float*)take((size_t)NTOK * 4);
    p.kc = (float*)take((size_t)NB * 256 * 64 * 4); p.vc = (float*)take((size_t)NB * 256 * 64 * 4);
    p.selmask = (unsigned long long*)take((size_t)NTOK * 8); p.btab = (float*)take((size_t)12 * BT_STRIDE * 4);

    k_btab<<<(12 * BT_STRIDE + 255) / 256, 256, 0, stream>>>(p);
    k_rowscale<<<NTOK / 4, 256, 0, stream>>>(p.x_in, p.rs);
    for (int l = 0; l < DEPTH; ++l) {
        k_gemm<0><<<dim3(NP / 128, NTOK / 128), 256, 0, stream>>>(p, l);
        k_mla_up<<<NTOK / 8, 256, 0, stream>>>(p, l);
        k_compress<<<dim3(32, 2, NB), 256, 0, stream>>>(p, l);
        k_cmp_attn<<<dim3(T / 64, NB), 256, 0, stream>>>(p);
        k_attn<3><<<dim3(T / 64, NB), 256, 0, stream>>>(p, l);
        k_attn<1><<<dim3(T / 64, NB), 256, 0, stream>>>(p, l);
        k_attn<0><<<dim3(T / 64, NB), 256, 0, stream>>>(p, l);
        k_attn<2><<<dim3(T / 64, NB, 2), 256, 0, stream>>>(p, l);
        k_gemm<1><<<dim3(D / 128, NTOK / 128), 256, 0, stream>>>(p, l);
        k_postnorm<<<NTOK / 4, 256, 0, stream>>>(p, l);
    }
}
```

```cpp
#include <hip/hip_runtime.h>
#include <hip/hip_cooperative_groups.h>
#include <stdint.h>
#include <cstdio>
namespace cg = cooperative_groups;

typedef unsigned short bf16_t;
#define DI __device__ __forceinline__

DI float bf2f(bf16_t v) { return __uint_as_float(((unsigned)v) << 16); }
DI bf16_t f2bf(float f) { unsigned u = __float_as_uint(f); u += 0x7fffu + ((u >> 16) & 1u); return (bf16_t)(u >> 16); }
DI float bflo(unsigned w) { return __uint_as_float(w << 16); }
DI float bfhi(unsigned w) { return __uint_as_float(w & 0xffff0000u); }

constexpr int NB = 4, T = 4096, D = 1024, NTOK = NB * T, DEPTH = 4, DIN = 2732, NP = 2816;
constexpr int C_AQ = 0, C_KCMP = 256, C_VCMP = 320, C_KSLC = 384, C_VSLC = 448, C_KWIN = 512, C_VWIN = 576;
constexpr int C_BCQ = 640, C_BCKV = 896, C_CQ = 1024, C_CK = 1536, C_CV = 1600, C_Z = 1664, C_BKR = 2688, C_AG = 2720;
constexpr int BT_STRIDE = 520;

__host__ __device__ inline int src_col(int n) {
    if (n < 640) return n;
    if (n < 896) return 652 + (n - 640);
    if (n < 1024) return 908 + (n - 896);
    if (n < 1536) return 1068 + (n - 1024);
    if (n < 1664) return 1580 + (n - 1536);
    if (n < 2688) return 1708 + (n - 1664);
    if (n < 2720) return 1036 + (n - 2688);
    if (n < 2732) return 640 + (n - 2720);
    return -1;
}

DI int t5_bucket(int d) {
    if (d < 16) return d < 0 ? 0 : d;
    int b = 16;
    b += d >= 20; b += d >= 25; b += d >= 31; b += d >= 39; b += d >= 48; b += d >= 59; b += d >= 73; b += d >= 91;
    b += d >= 113; b += d >= 140; b += d >= 174; b += d >= 216; b += d >= 268; b += d >= 332; b += d >= 413;
    return b;
}

struct Params {
    const float* x_in; const float* w_in; const float* w_out; const float* norm_pre; const float* norm_post;
    const float* cmp_pos; const float* cmp_w1; const float* cmp_w2; const float* q_norm; const float* w_uq;
    const float* kv_norm; const float* w_ukv; const float* sinks; const float* rel_bias;
    float* xout;
    bf16_t* P;
    float* y;
    bf16_t* Qm;
    bf16_t* Km;
    bf16_t* Vm;
    bf16_t* mixed;
    float* oa;
    float* rs;
    float* kc;
    float* vc;
    unsigned long long* selmask;
    float* btab;
};

DI void b_btab(const Params& p, int vb) {
    int i = vb * 256 + threadIdx.x;
    if (i < 12 * BT_STRIDE) { int h = i / BT_STRIDE, d = i % BT_STRIDE; p.btab[i] = p.rel_bias[h * 32 + t5_bucket(d)]; }
}

DI void b_rowscale(const float* x, float* rs, int vb) {
    int row = vb * 4 + (threadIdx.x >> 6), lane = threadIdx.x & 63;
    const float4* xp = (const float4*)(x + (size_t)row * D);
    float s = 0.f;
    for (int i = lane; i < D / 4; i += 64) { float4 v = xp[i]; s += v.x * v.x + v.y * v.y + v.z * v.z + v.w * v.w; }
    for (int o = 32; o > 0; o >>= 1) s += __shfl_xor(s, o);
    if (lane == 0) rs[row] = rsqrtf(s * (1.0f / D) + 1e-6f);
}

template <int MODE>
DI void b_gemm(const Params& p, int layer, int bx, int by, char* smem) {
    float (*As)[132] = (float (*)[132])smem;
    float (*Bs)[132] = (float (*)[132])(smem + 8 * 132 * 4);
    const int tid = threadIdx.x, tx = tid & 15, ty = tid >> 4;
    const int m0 = by * 128, n0 = bx * 128;
    const float* x = (layer == 0) ? p.x_in : p.xout;
    const float* W = MODE == 0 ? p.w_in + (size_t)layer * D * DIN : p.w_out + (size_t)layer * D * D;
    const float* g = p.norm_pre + layer * D;
    float acc[8][8];
#pragma unroll
    for (int i = 0; i < 8; ++i)
#pragma unroll
        for (int j = 0; j < 8; ++j) acc[i][j] = 0.f;
    const int arow = tid >> 1, ak4 = (tid & 1) * 4;
    const int bk = tid >> 5, bn4 = (tid & 31) * 4;
    int bsrc = 0;
    if (MODE == 0) bsrc = src_col(n0 + bn4); else bsrc = n0 + bn4;
    for (int k0 = 0; k0 < D; k0 += 8) {
        float4 av;
        if (MODE == 0) av = *(const float4*)(x + (size_t)(m0 + arow) * D + k0 + ak4);
        else { const uint2 w = *(const uint2*)(p.mixed + (size_t)(m0 + arow) * D + k0 + ak4); av = make_float4(bflo(w.x), bfhi(w.x), bflo(w.y), bfhi(w.y)); }
        float4 bv = make_float4(0.f, 0.f, 0.f, 0.f);
        if (bsrc >= 0) {
            bv = *(const float4*)(W + (size_t)(k0 + bk) * (MODE == 0 ? DIN : D) + bsrc);
            if (MODE == 0) { const float gg = g[k0 + bk]; bv.x *= gg; bv.y *= gg; bv.z *= gg; bv.w *= gg; }
        }
        __syncthreads();
        As[ak4 + 0][arow] = av.x; As[ak4 + 1][arow] = av.y; As[ak4 + 2][arow] = av.z; As[ak4 + 3][arow] = av.w;
        *(float4*)&Bs[bk][bn4] = bv;
        __syncthreads();
#pragma unroll
        for (int kk = 0; kk < 8; ++kk) {
            float a[8], b[8];
            *(float4*)&a[0] = *(const float4*)&As[kk][ty * 4]; *(float4*)&a[4] = *(const float4*)&As[kk][64 + ty * 4];
            *(float4*)&b[0] = *(const float4*)&Bs[kk][tx * 4]; *(float4*)&b[4] = *(const float4*)&Bs[kk][64 + tx * 4];
#pragma unroll
            for (int i = 0; i < 8; ++i)
#pragma unroll
                for (int j = 0; j < 8; ++j) acc[i][j] += a[i] * b[j];
        }
    }
#pragma unroll
    for (int i = 0; i < 8; ++i) {
        const int row = m0 + (i < 4 ? ty * 4 + i : 64 + ty * 4 + (i - 4));
        if (MODE == 0) {
            const float r = p.rs[row];
#pragma unroll
            for (int jj = 0; jj < 2; ++jj) {
                const int col = n0 + jj * 64 + tx * 4;
                uint2 w; w.x = (unsigned)f2bf(acc[i][jj * 4 + 0] * r) | ((unsigned)f2bf(acc[i][jj * 4 + 1] * r) << 16);
                w.y = (unsigned)f2bf(acc[i][jj * 4 + 2] * r) | ((unsigned)f2bf(acc[i][jj * 4 + 3] * r) << 16);
                *(uint2*)(p.P + (size_t)row * NP + col) = w;
            }
        } else {
#pragma unroll
            for (int jj = 0; jj < 2; ++jj) {
                const int col = n0 + jj * 64 + tx * 4;
                *(float4*)(p.y + (size_t)row * D + col) = make_float4(acc[i][jj * 4 + 0], acc[i][jj * 4 + 1], acc[i][jj * 4 + 2], acc[i][jj * 4 + 3]);
            }
        }
    }
}

DI void b_mla_up(const Params& p, int layer, int vb, char* smem) {
    float (*cq)[256] = (float (*)[256])smem;
    float (*ckv)[128] = (float (*)[128])(smem + 8192);
    float (*qb)[384] = (float (*)[384])(smem + 8192 + 4096);
    float (*red)[2] = (float (*)[2])(smem + 8192 + 4096 + 12288);
    const int tid = threadIdx.x, tok0 = vb * 8;
    {
        const int tk = tid >> 5, l32 = tid & 31;
        float s1 = 0.f, s2 = 0.f;
        for (int k = l32; k < 256; k += 32) { float v = bf2f(p.P[(size_t)(tok0 + tk) * NP + C_BCQ + k]); cq[tk][k] = v; s1 += v * v; }
        for (int k = l32; k < 128; k += 32) { float v = bf2f(p.P[(size_t)(tok0 + tk) * NP + C_BCKV + k]); ckv[tk][k] = v; s2 += v * v; }
        for (int o = 16; o > 0; o >>= 1) { s1 += __shfl_xor(s1, o); s2 += __shfl_xor(s2, o); }
        if (l32 == 0) { red[tk][0] = rsqrtf(s1 * (1.f / 256.f) + 1e-6f); red[tk][1] = rsqrtf(s2 * (1.f / 128.f) + 1e-6f); }
    }
    __syncthreads();
    {
        const int tk = tid >> 5, l32 = tid & 31;
        for (int k = l32; k < 256; k += 32) cq[tk][k] *= red[tk][0] * p.q_norm[layer * 256 + k];
        for (int k = l32; k < 128; k += 32) ckv[tk][k] *= red[tk][1] * p.kv_norm[layer * 128 + k];
    }
    __syncthreads();
    const float* wq = p.w_uq + (size_t)layer * 256 * 384;
    for (int j = tid; j < 384; j += 256) {
        float acc[8] = {0, 0, 0, 0, 0, 0, 0, 0};
        for (int k = 0; k < 256; ++k) { const float w = wq[k * 384 + j];
#pragma unroll
            for (int tk = 0; tk < 8; ++tk) acc[tk] += cq[tk][k] * w; }
#pragma unroll
        for (int tk = 0; tk < 8; ++tk) qb[tk][j] = acc[tk];
    }
    const float* wkv = p.w_ukv + (size_t)layer * 128 * 512;
    for (int j = tid; j < 512; j += 256) {
        float acc[8] = {0, 0, 0, 0, 0, 0, 0, 0};
        for (int k = 0; k < 128; ++k) { const float w = wkv[k * 512 + j];
#pragma unroll
            for (int tk = 0; tk < 8; ++tk) acc[tk] += ckv[tk][k] * w; }
        const int h = j >> 7, e = j & 127;
#pragma unroll
        for (int tk = 0; tk < 8; ++tk) {
            if (e < 64) p.Km[(size_t)(tok0 + tk) * 384 + h * 96 + e] = f2bf(acc[tk]);
            else p.Vm[(size_t)(tok0 + tk) * 256 + h * 64 + (e - 64)] = f2bf(acc[tk]);
        }
    }
    __syncthreads();
    for (int idx = tid; idx < 8 * 4 * 64; idx += 256) {
        const int tk = idx >> 8, h = (idx >> 6) & 3, e = idx & 63;
        p.Qm[(size_t)(tok0 + tk) * 384 + h * 96 + e] = f2bf(qb[tk][h * 96 + e]);
    }
    for (int idx = tid; idx < 8 * 5 * 16; idx += 256) {
        const int tk = idx / 80, r = idx % 80, h = r >> 4, i = r & 15;
        const int tok = tok0 + tk, pos = tok % T;
        const float inv = powf(10000.0f, -(float)i / 16.0f);
        const float ang = (float)pos * inv;
        const float cs = cosf(ang), sn = sinf(ang);
        if (h < 4) {
            const float x1 = qb[tk][h * 96 + 64 + i], x2 = qb[tk][h * 96 + 80 + i];
            p.Qm[(size_t)tok * 384 + h * 96 + 64 + i] = f2bf(x1 * cs - x2 * sn);
            p.Qm[(size_t)tok * 384 + h * 96 + 80 + i] = f2bf(x2 * cs + x1 * sn);
        } else {
            const float x1 = bf2f(p.P[(size_t)tok * NP + C_BKR + i]), x2 = bf2f(p.P[(size_t)tok * NP + C_BKR + 16 + i]);
            const bf16_t o1 = f2bf(x1 * cs - x2 * sn), o2 = f2bf(x2 * cs + x1 * sn);
            for (int hh = 0; hh < 4; ++hh) { p.Km[(size_t)tok * 384 + hh * 96 + 64 + i] = o1; p.Km[(size_t)tok * 384 + hh * 96 + 80 + i] = o2; }
        }
    }
}

DI void b_compress(const Params& p, int layer, int bx, int which, int b, char* smem) {
    float (*tok)[64] = (float (*)[64])smem;
    float (*pe)[64] = (float (*)[64])(smem + 144 * 64 * 4);
    float (*hid)[128] = (float (*)[128])(smem + 144 * 64 * 4 + 32 * 64 * 4);
    const int tid = threadIdx.x, c0 = bx * 8;
    const int col = which == 0 ? C_KCMP : C_VCMP;
    for (int idx = tid; idx < 144 * 64; idx += 256) {
        const int r = idx >> 6, d = idx & 63, t = c0 * 16 + r;
        tok[r][d] = t < T ? bf2f(p.P[(size_t)(b * T + t) * NP + col + d]) : 0.f;
    }
    const float* pep = p.cmp_pos + ((size_t)layer * 2 + which) * 32 * 64;
    for (int idx = tid; idx < 32 * 64; idx += 256) pe[idx >> 6][idx & 63] = pep[idx];
    __syncthreads();
    const int j = tid & 127, half = tid >> 7;
    const float* w1 = p.cmp_w1 + ((size_t)layer * 2 + which) * 2048 * 128;
    float acc[4] = {0, 0, 0, 0};
    for (int i = 0; i < 32; ++i)
        for (int d = 0; d < 64; ++d) {
            const float w = w1[(size_t)(i * 64 + d) * 128 + j], pp = pe[i][d];
#pragma unroll
            for (int cc = 0; cc < 4; ++cc) acc[cc] += (tok[(half * 4 + cc) * 16 + i][d] + pp) * w;
        }
#pragma unroll
    for (int cc = 0; cc < 4; ++cc) { const float a = acc[cc]; hid[half * 4 + cc][j] = a / (1.f + expf(-a)); }
    __syncthreads();
    const float* w2 = p.cmp_w2 + ((size_t)layer * 2 + which) * 128 * 64;
    float* outp = which == 0 ? p.kc : p.vc;
    for (int idx = tid; idx < 8 * 64; idx += 256) {
        const int cc = idx >> 6, d = idx & 63, c = c0 + cc;
        float s = 0.f;
        for (int jj = 0; jj < 128; ++jj) s += hid[cc][jj] * w2[jj * 64 + d];
        if (c < 255) outp[((size_t)b * 256 + c) * 64 + d] = s;
    }
}

DI void b_cmp_attn(const Params& p, int bx, int b, char* smem) {
    float (*imp)[65] = (float (*)[65])smem;
    const int tid = threadIdx.x, tl = tid >> 2, h = tid & 3;
    const int t0 = bx * 64, t = t0 + tl;
    const size_t tok = (size_t)b * T + t;
    float q[64];
    {
        const uint4* qp = (const uint4*)(p.P + tok * NP + C_AQ + h * 64);
#pragma unroll
        for (int c = 0; c < 8; ++c) { const uint4 w = qp[c];
            q[c * 8 + 0] = bflo(w.x); q[c * 8 + 1] = bfhi(w.x); q[c * 8 + 2] = bflo(w.y); q[c * 8 + 3] = bfhi(w.y);
            q[c * 8 + 4] = bflo(w.z); q[c * 8 + 5] = bfhi(w.z); q[c * 8 + 6] = bflo(w.w); q[c * 8 + 7] = bfhi(w.w); }
    }
    const int nv = t >= 31 ? min(255, (t - 31) / 16 + 1) : 0;
    const int nvmax = (t0 + 63 >= 31) ? min(255, (t0 + 63 - 31) / 16 + 1) : 0;
    const float* kcb = p.kc + (size_t)b * 256 * 64;
    const float* vcb = p.vc + (size_t)b * 256 * 64;
    const float* bt = p.btab + h * BT_STRIDE;
    float m = -1e30f, l = 0.f;
    for (int c = 0; c < nvmax; ++c) {
        const float4* kp = (const float4*)(kcb + c * 64);
        float s = 0.f;
#pragma unroll
        for (int d4 = 0; d4 < 16; ++d4) { const float4 kv = kp[d4]; s += q[d4 * 4] * kv.x + q[d4 * 4 + 1] * kv.y + q[d4 * 4 + 2] * kv.z + q[d4 * 4 + 3] * kv.w; }
        if (c < nv) {
            const int dist = t - (16 * c + 31);
            s = s * 0.125f + bt[min(dist, 512)];
            const float mn = fmaxf(m, s);
            l = l * expf(m - mn) + expf(s - mn); m = mn;
        }
    }
    const float invl = nv > 0 ? 1.f / l : 0.f;
    float o[64];
#pragma unroll
    for (int d = 0; d < 64; ++d) o[d] = 0.f;
    float prev3 = 0.f;
    for (int s4 = 0; s4 < 64; ++s4) {
        float pc[4];
#pragma unroll
        for (int r = 0; r < 4; ++r) {
            const int c = s4 * 4 + r;
            float pr = 0.f;
            if (c < nvmax) {
                const float4* kp = (const float4*)(kcb + c * 64);
                float s = 0.f;
#pragma unroll
                for (int d4 = 0; d4 < 16; ++d4) { const float4 kv = kp[d4]; s += q[d4 * 4] * kv.x + q[d4 * 4 + 1] * kv.y + q[d4 * 4 + 2] * kv.z + q[d4 * 4 + 3] * kv.w; }
                if (c < nv) {
                    const int dist = t - (16 * c + 31);
                    s = s * 0.125f + bt[min(dist, 512)];
                    pr = expf(s - m) * invl;
                    const float4* vp = (const float4*)(vcb + c * 64);
#pragma unroll
                    for (int d4 = 0; d4 < 16; ++d4) { const float4 vv = vp[d4]; o[d4 * 4] += pr * vv.x; o[d4 * 4 + 1] += pr * vv.y; o[d4 * 4 + 2] += pr * vv.z; o[d4 * 4 + 3] += pr * vv.w; }
                }
            }
            pc[r] = pr;
        }
        float v = 2.f * (pc[0] + pc[1] + pc[2]) + pc[3] + prev3;
        prev3 = pc[3];
        v += __shfl_xor(v, 1); v += __shfl_xor(v, 2);
        if (h == 0) imp[tl][s4] = v;
    }
    {
        const float gl = bf2f(p.P[tok * NP + C_AG + h * 3 + 0]);
        const float gt = 1.f / (1.f + expf(-gl));
        float* op = p.oa + tok * 256 + h * 64;
#pragma unroll
        for (int d4 = 0; d4 < 16; ++d4) *(float4*)(op + d4 * 4) = make_float4(gt * o[d4 * 4], gt * o[d4 * 4 + 1], gt * o[d4 * 4 + 2], gt * o[d4 * 4 + 3]);
    }
    __syncthreads();
    if (h == 0) {
        const int cur = t >> 6;
        unsigned long long mask;
        if (cur + 1 <= 16) mask = (cur == 63) ? ~0ull : ((1ull << (cur + 1)) - 1ull);
        else {
            mask = 1ull | (1ull << cur) | (1ull << (cur - 1));
            for (int it = 0; it < 13; ++it) {
                float best = -3e38f; int bi = -1;
                for (int s = 1; s <= cur - 2; ++s) { const float v = imp[tl][s]; if (!((mask >> s) & 1ull) && v > best) { best = v; bi = s; } }
                if (bi >= 0) mask |= 1ull << bi;
            }
        }
        p.selmask[tok] = mask;
    }
}

template <int MODE>
DI void b_attn(const Params& p, int layer, int bx, int b, int bz) {
    constexpr int DK = MODE == 0 ? 96 : 64;
    const int tid = threadIdx.x, tl = tid & 63, hh = tid >> 6;
    const int t0 = bx * 64, t = t0 + tl;
    const int h = (MODE == 2 ? bz * 4 : 0) + hh;
    const size_t tok = (size_t)b * T + t;
    const bf16_t *Kb, *Vb, *qp; int kst, vst; float scale; const float* bt = nullptr; int W;
    if (MODE == 0) { Kb = p.Km + (size_t)b * T * 384 + h * 96; Vb = p.Vm + (size_t)b * T * 256 + h * 64; kst = 384; vst = 256; qp = p.Qm + tok * 384 + h * 96; scale = 0.10206207261596577f; W = 1 << 30; }
    if (MODE == 1) { Kb = p.P + (size_t)b * T * NP + C_KWIN; Vb = p.P + (size_t)b * T * NP + C_VWIN; kst = NP; vst = NP; qp = p.P + tok * NP + C_AQ + h * 64; scale = 0.125f; bt = p.btab + h * BT_STRIDE; W = 512; }
    if (MODE == 2) { Kb = p.P + (size_t)b * T * NP + C_CK; Vb = p.P + (size_t)b * T * NP + C_CV; kst = NP; vst = NP; qp = p.P + tok * NP + C_CQ + h * 64; scale = 0.125f; bt = p.btab + (4 + h) * BT_STRIDE; W = 128; }
    if (MODE == 3) { Kb = p.P + (size_t)b * T * NP + C_KSLC; Vb = p.P + (size_t)b * T * NP + C_VSLC; kst = NP; vst = NP; qp = p.P + tok * NP + C_AQ + h * 64; scale = 0.125f; bt = p.btab + h * BT_STRIDE; W = 1 << 30; }
    float q[DK];
#pragma unroll
    for (int c = 0; c < DK / 8; ++c) { const uint4 w = ((const uint4*)qp)[c];
        q[c * 8 + 0] = bflo(w.x); q[c * 8 + 1] = bfhi(w.x); q[c * 8 + 2] = bflo(w.y); q[c * 8 + 3] = bfhi(w.y);
        q[c * 8 + 4] = bflo(w.z); q[c * 8 + 5] = bfhi(w.z); q[c * 8 + 6] = bflo(w.w); q[c * 8 + 7] = bfhi(w.w); }
    float o[64];
#pragma unroll
    for (int d = 0; d < 64; ++d) o[d] = 0.f;
    float m = -1e30f, l = 0.f;
    unsigned long long mask = ~0ull;
    if (MODE == 3) mask = p.selmask[tok];
    const int jlo = (MODE == 1 || MODE == 2) ? max(0, t0 - (W - 1)) : 0;
    const int jhi = t0 + 63;
    for (int j = jlo; j <= jhi; ++j) {
        if (MODE == 3) { if ((j & 63) == 0 && !__any((int)((mask >> (j >> 6)) & 1ull))) { j += 63; continue; } }
        const uint4* kp = (const uint4*)(Kb + (size_t)j * kst);
        float s = 0.f;
#pragma unroll
        for (int c = 0; c < DK / 8; ++c) { const uint4 w = kp[c];
            s += q[c * 8 + 0] * bflo(w.x) + q[c * 8 + 1] * bfhi(w.x) + q[c * 8 + 2] * bflo(w.y) + q[c * 8 + 3] * bfhi(w.y)
               + q[c * 8 + 4] * bflo(w.z) + q[c * 8 + 5] * bfhi(w.z) + q[c * 8 + 6] * bflo(w.w) + q[c * 8 + 7] * bfhi(w.w); }
        const int dist = t - j;
        bool valid = dist >= 0 && dist < W;
        if (MODE == 3) valid = valid && ((mask >> (j >> 6)) & 1ull);
        if (valid) {
            s *= scale;
            if (MODE != 0) s += bt[min(dist, 512)];
            const float mn = fmaxf(m, s), a = expf(m - mn), pr = expf(s - mn);
            l = l * a + pr; m = mn;
            const uint4* vp = (const uint4*)(Vb + (size_t)j * vst);
#pragma unroll
            for (int c = 0; c < 8; ++c) { const uint4 w = vp[c];
                o[c * 8 + 0] = o[c * 8 + 0] * a + pr * bflo(w.x); o[c * 8 + 1] = o[c * 8 + 1] * a + pr * bfhi(w.x);
                o[c * 8 + 2] = o[c * 8 + 2] * a + pr * bflo(w.y); o[c * 8 + 3] = o[c * 8 + 3] * a + pr * bfhi(w.y);
                o[c * 8 + 4] = o[c * 8 + 4] * a + pr * bflo(w.z); o[c * 8 + 5] = o[c * 8 + 5] * a + pr * bfhi(w.z);
                o[c * 8 + 6] = o[c * 8 + 6] * a + pr * bflo(w.w); o[c * 8 + 7] = o[c * 8 + 7] * a + pr * bfhi(w.w); }
        }
    }
    if (MODE == 2) { const float sk = p.sinks[layer * 8 + h]; const float mn = fmaxf(m, sk); const float a = expf(m - mn); l = l * a + expf(sk - mn);
#pragma unroll
        for (int d = 0; d < 64; ++d) o[d] *= a; }
    const float invl = 1.f / l;
    if (MODE == 3) {
        const float gl = bf2f(p.P[tok * NP + C_AG + h * 3 + 1]);
        const float gt = invl / (1.f + expf(-gl));
        float* op = p.oa + tok * 256 + h * 64;
#pragma unroll
        for (int d = 0; d < 64; ++d) op[d] += gt * o[d];
    } else {
        float gt = invl; int mcol;
        if (MODE == 1) { const float gl = bf2f(p.P[tok * NP + C_AG + h * 3 + 2]); gt = invl / (1.f + expf(-gl)); mcol = h * 64; }
        else if (MODE == 0) mcol = 256 + h * 64; else mcol = 512 + h * 64;
        const bf16_t* zp = p.P + tok * NP + C_Z + mcol;
        bf16_t* mp = p.mixed + tok * 1024 + mcol;
        const float* op = p.oa + tok * 256 + h * 64;
#pragma unroll
        for (int d = 0; d < 64; ++d) {
            float v = gt * o[d]; if (MODE == 1) v += op[d];
            const float z = bf2f(zp[d]);
            mp[d] = f2bf(v * z / (1.f + expf(-z)));
        }
    }
}

DI void b_postnorm(const Params& p, int layer, int vb) {
    const int row = vb * 4 + (threadIdx.x >> 6), lane = threadIdx.x & 63;
    const float* x = (layer == 0 ? p.x_in : p.xout) + (size_t)row * D;
    const float* y = p.y + (size_t)row * D;
    const float* g = p.norm_post + layer * D;
    float4 yv[4]; float s = 0.f;
#pragma unroll
    for (int i = 0; i < 4; ++i) { yv[i] = ((const float4*)y)[lane + 64 * i]; s += yv[i].x * yv[i].x + yv[i].y * yv[i].y + yv[i].z * yv[i].z + yv[i].w * yv[i].w; }
    for (int o = 32; o > 0; o >>= 1) s += __shfl_xor(s, o);
    const float r = rsqrtf(s * (1.f / D) + 1e-6f);
    float s2 = 0.f;
#pragma unroll
    for (int i = 0; i < 4; ++i) {
        const float4 xv = ((const float4*)x)[lane + 64 * i], gv = ((const float4*)g)[lane + 64 * i];
        float4 o; o.x = xv.x + yv[i].x * r * gv.x; o.y = xv.y + yv[i].y * r * gv.y; o.z = xv.z + yv[i].z * r * gv.z; o.w = xv.w + yv[i].w * r * gv.w;
        ((float4*)(p.xout + (size_t)row * D))[lane + 64 * i] = o;
        s2 += o.x * o.x + o.y * o.y + o.z * o.z + o.w * o.w;
    }
    for (int o = 32; o > 0; o >>= 1) s2 += __shfl_xor(s2, o);
    if (lane == 0) p.rs[row] = rsqrtf(s2 * (1.f / D) + 1e-6f);
}

constexpr int SMEM_BYTES = 144 * 64 * 4 + 32 * 64 * 4 + 8 * 128 * 4;

__global__ void __launch_bounds__(256) mega(Params p) {
    extern __shared__ __attribute__((aligned(16))) char smem[];
    cg::grid_group grid = cg::this_grid();
    const int G = gridDim.x, bid = blockIdx.x;
    for (int vb = bid; vb < (12 * BT_STRIDE + 255) / 256; vb += G) b_btab(p, vb);
    for (int vb = bid; vb < NTOK / 4; vb += G) b_rowscale(p.x_in, p.rs, vb);
    grid.sync();
    for (int l = 0; l < DEPTH; ++l) {
        for (int vb = bid; vb < (NP / 128) * (NTOK / 128); vb += G) { b_gemm<0>(p, l, vb % (NP / 128), vb / (NP / 128), smem); __syncthreads(); }
        grid.sync();
        for (int vb = bid; vb < 256 + NTOK / 8; vb += G) {
            if (vb < 256) b_compress(p, l, vb & 31, (vb >> 5) & 1, vb >> 6, smem); else b_mla_up(p, l, vb - 256, smem);
            __syncthreads();
        }
        grid.sync();
        for (int vb = bid; vb < 256 + 512; vb += G) {
            if (vb < 256) { b_cmp_attn(p, vb & 63, vb >> 6, smem); __syncthreads(); }
            else { const int u = vb - 256; b_attn<2>(p, l, u & 63, (u >> 6) & 3, u >> 8); }
        }
        grid.sync();
        for (int vb = bid; vb < 512; vb += G) {
            const int u = vb >> 1, tile = 63 - (u >> 2), b = u & 3;
            if (vb & 1) { b_attn<3>(p, l, tile, b, 0); b_attn<1>(p, l, tile, b, 0); }
            else b_attn<0>(p, l, tile, b, 0);
        }
        grid.sync();
        for (int vb = bid; vb < (D / 128) * (NTOK / 128); vb += G) { b_gemm<1>(p, l, vb % (D / 128), vb / (D / 128), smem); __syncthreads(); }
        grid.sync();
        for (int vb = bid; vb < NTOK / 4; vb += G) b_postnorm(p, l, vb);
        grid.sync();
    }
}


extern "C" void kernel_launch(void* const* d_in, const int* in_sizes, int n_in, void* d_out, int out_size, void* d_ws, size_t ws_size, hipStream_t stream) {
    Params p{};
    p.x_in = (const float*)d_in[0]; p.w_in = (const float*)d_in[1]; p.w_out = (const float*)d_in[2]; p.norm_pre = (const float*)d_in[3]; p.norm_post = (const float*)d_in[4];
    p.cmp_pos = (const float*)d_in[5]; p.cmp_w1 = (const float*)d_in[6]; p.cmp_w2 = (const float*)d_in[7]; p.q_norm = (const float*)d_in[8]; p.w_uq = (const float*)d_in[9];
    p.kv_norm = (const float*)d_in[10]; p.w_ukv = (const float*)d_in[11]; p.sinks = (const float*)d_in[12]; p.rel_bias = (const float*)d_in[13];
    p.xout = (float*)d_out;
    char* w = (char*)d_ws; size_t off = 0;
    auto take = [&](size_t bytes) { char* r = w + off; off += (bytes + 255) & ~(size_t)255; return r; };
    p.P = (bf16_t*)take((size_t)NTOK * NP * 2); p.y = (float*)p.P;
    p.Qm = (bf16_t*)take((size_t)NTOK * 384 * 2); p.Km = (bf16_t*)take((size_t)NTOK * 384 * 2); p.Vm = (bf16_t*)take((size_t)NTOK * 256 * 2);
    p.mixed = (bf16_t*)take((size_t)NTOK * 1024 * 2); p.oa = (float*)take((size_t)NTOK * 256 * 4); p.rs = (float*)take((size_t)NTOK * 4);
    p.kc = (float*)take((size_t)NB * 256 * 64 * 4); p.vc = (float*)take((size_t)NB * 256 * 64 * 4);
    p.selmask = (unsigned long long*)take((size_t)NTOK * 8); p.btab = (float*)take((size_t)12 * BT_STRIDE * 4);

    static int grid_blocks = 0;
    if (!grid_blocks) {
        int dev = 0, cus = 0, per_cu = 0;
        hipGetDevice(&dev);
        hipDeviceGetAttribute(&cus, hipDeviceAttributeMultiprocessorCount, dev);
        hipOccupancyMaxActiveBlocksPerMultiprocessor(&per_cu, mega, 256, SMEM_BYTES);
        if (per_cu > 2) per_cu = 2;
        grid_blocks = cus * per_cu;
    }
    void* args[] = {&p};
    hipError_t e = hipLaunchCooperativeKernel((void*)mega, dim3(grid_blocks), dim3(256), args, SMEM_BYTES, stream);
    if (e != hipSuccess) fprintf(stderr, "cooperative launch failed: %s (grid %d)\n", hipGetErrorString(e), grid_blocks);
}
```

```cpp
#include <hip/hip_runtime.h>
#include <hip/hip_cooperative_groups.h>
#include <stdint.h>
#include <cstdio>
namespace cg = cooperative_groups;

typedef unsigned short bf16_t;
#define DI __device__ __forceinline__

DI float bf2f(bf16_t v) { return __uint_as_float(((unsigned)v) << 16); }
DI bf16_t f2bf(float f) { unsigned u = __float_as_uint(f); u += 0x7fffu + ((u >> 16) & 1u); return (bf16_t)(u >> 16); }
DI float bflo(unsigned w) { return __uint_as_float(w << 16); }
DI float bfhi(unsigned w) { return __uint_as_float(w & 0xffff0000u); }
DI unsigned pk2(float lo, float hi) { return (unsigned)f2bf(lo) | ((unsigned)f2bf(hi) << 16); }

constexpr int NB = 4, T = 4096, D = 1024, NTOK = NB * T, DEPTH = 4, DIN = 2732, NP = 2816;
constexpr int C_AQ = 0, C_KCMP = 256, C_VCMP = 320, C_KSLC = 384, C_VSLC = 448, C_KWIN = 512, C_VWIN = 576, C_CK = 640, C_CV = 704;
constexpr int C_BCQ = 768, C_BCKV = 1024, C_BKR = 1152, C_AG = 1184, C_CQ = 1280, C_Z = 1792;
constexpr int BT_STRIDE = 520;

__host__ __device__ inline int src_col(int n) {
    if (n < 640) return n;
    if (n < 768) return 1580 + (n - 640);
    if (n < 1024) return 652 + (n - 768);
    if (n < 1152) return 908 + (n - 1024);
    if (n < 1184) return 1036 + (n - 1152);
    if (n < 1196) return 640 + (n - 1184);
    if (n < 1280) return -1;
    if (n < 1792) return 1068 + (n - 1280);
    return 1708 + (n - 1792);
}

DI int t5_bucket(int d) {
    if (d < 16) return d < 0 ? 0 : d;
    int b = 16;
    b += d >= 20; b += d >= 25; b += d >= 31; b += d >= 39; b += d >= 48; b += d >= 59; b += d >= 73; b += d >= 91;
    b += d >= 113; b += d >= 140; b += d >= 174; b += d >= 216; b += d >= 268; b += d >= 332; b += d >= 413;
    return b;
}

constexpr size_t al256(size_t x) { return (x + 255) & ~(size_t)255; }
constexpr size_t WS_P = 0;
constexpr size_t WS_XB = WS_P + al256((size_t)NTOK * NP * 2 + 65536);
constexpr size_t WS_WTIN = WS_XB + al256((size_t)NTOK * D * 2);
constexpr size_t WS_WTOUT = WS_WTIN + al256((size_t)DEPTH * NP * D * 2);
constexpr size_t WS_QM = WS_WTOUT + al256((size_t)DEPTH * D * D * 2);
constexpr size_t WS_KM = WS_QM + al256((size_t)NTOK * 384 * 2);
constexpr size_t WS_VM = WS_KM + al256((size_t)NTOK * 384 * 2);
constexpr size_t WS_MIX = WS_VM + al256((size_t)NTOK * 256 * 2);
constexpr size_t WS_OA = WS_MIX + al256((size_t)NTOK * 1024 * 2);
constexpr size_t WS_RS = WS_OA + al256((size_t)NTOK * 256 * 4);
constexpr size_t WS_SSQQ = WS_RS + al256((size_t)NTOK * 4);
constexpr size_t WS_SSQKV = WS_SSQQ + al256((size_t)NTOK * 16);
constexpr size_t WS_KC = WS_SSQKV + al256((size_t)NTOK * 16);
constexpr size_t WS_VC = WS_KC + al256((size_t)NB * 256 * 64 * 4);
constexpr size_t WS_SEL = WS_VC + al256((size_t)NB * 256 * 64 * 4);
constexpr size_t WS_BTAB = WS_SEL + al256((size_t)NTOK * 8);
constexpr size_t WS_END = WS_BTAB + al256((size_t)12 * BT_STRIDE * 4);

struct Params {
    const float* in[14]; float* xout; char* ws;
#define PF(name, idx) DI const float* name() const { return in[idx]; }
    PF(x_in_, 0) PF(w_in_, 1) PF(w_out_, 2) PF(norm_pre_, 3) PF(norm_post_, 4) PF(cmp_pos_, 5) PF(cmp_w1_, 6) PF(cmp_w2_, 7) PF(q_norm_, 8) PF(w_uq_, 9) PF(kv_norm_, 10) PF(w_ukv_, 11) PF(sinks_, 12) PF(rel_bias_, 13)
#undef PF
};
#define x_in x_in_()
#define w_in w_in_()
#define w_out w_out_()
#define norm_pre norm_pre_()
#define norm_post norm_post_()
#define cmp_pos cmp_pos_()
#define cmp_w1 cmp_w1_()
#define cmp_w2 cmp_w2_()
#define q_norm q_norm_()
#define w_uq w_uq_()
#define kv_norm kv_norm_()
#define w_ukv w_ukv_()
#define sinks sinks_()
#define rel_bias rel_bias_()

namespace pg8 {
#define PG8_LAS __attribute__((address_space(3)))
typedef short bf16x8 __attribute__((ext_vector_type(8)));
typedef float f32x4 __attribute__((ext_vector_type(4)));
typedef unsigned u32x4 __attribute__((ext_vector_type(4)));
constexpr int BM = 256, BK = 64, HALF = 128, HTB = HALF * BK * 2  , STAGE_BYTES = 8 * HTB, NXCD = 8, WGM = 8;

__host__ __device__ __forceinline__ int lds_byte(int r, int c) { const int st = (r >> 4) * 2 + (c >> 5), rr = r & 15, cc = c & 31, ob = rr * 64 + cc * 2; return st * 1024 + (ob ^ (((ob >> 9) & 1) << 5)); }
__host__ __device__ __forceinline__ void stage_rc(int b, int& R, int& C) { const int st = b / 1024, sb = b % 1024, swz = sb ^ (((sb >> 9) & 1) << 5); R = (st >> 1) * 16 + swz / 64; C = (st & 1) * 32 + (swz % 64) / 2; }
__host__ __device__ __forceinline__ int perm32(int rho) { const int n = rho >> 4, i = rho & 15; return 8 * (i >> 2) + 4 * n + (i & 3); }

struct Unit { int pm, pn; };
struct Gemm { const bf16_t* A; const bf16_t* Bt; int M, N, K, lda; };

struct StaticOrder {
    int nM, nN, nwg, G, c;
    __host__ __device__ void init(int M, int N, int G_, int c_) { nM = M / BM; nN = N / BM; nwg = nM * nN; G = G_; c = c_; }
    __host__ __device__ bool next(int i, Unit& u) const {
        const long L = (long)i * G + c; if (L >= nwg) return false;
        int wgid = (int)L; { const int q = nwg / NXCD, r = nwg % NXCD, xcd = wgid % NXCD, off = wgid / NXCD; wgid = (xcd < r ? xcd * (q + 1) : r * (q + 1) + (xcd - r) * q) + off; }
        const int nig = WGM * nN, gid = wgid / nig, fm = gid * WGM, gsz = (nM - fm) < WGM ? (nM - fm) : WGM;
        u.pm = fm + ((wgid % nig) % gsz); u.pn = (wgid % nig) / gsz; return true;
    }
    __device__ __forceinline__ void a_ready(const Unit&) const {}
    __device__ __forceinline__ void done(const Unit&) const {}
};

template <class Epi, class Sched, bool ALIGN_EPI = false, bool SP2 = false>
__device__ __forceinline__ void gemm_phase(PG8_LAS unsigned char* lds, const Gemm g, const Sched& S, const Epi& E) {
    const int tid = threadIdx.x, wid = __builtin_amdgcn_readfirstlane(tid >> 6), lane = tid & 63, wr = wid >> 2, wc = wid & 3, fr = lane & 15, fq = lane >> 4;
    const int K = g.K, nt = K / BK, lda = g.lda;
    unsigned voffA[2], voffB[2];
#pragma unroll
    for (int i = 0; i < 2; ++i) { int R, C; stage_rc(tid * 16 + i * 8192, R, C); const int Rb = Epi::PERM ? ((R & ~31) + perm32(R & 31)) : R;
        voffA[i] = (unsigned)(R * lda + C) * 2u; voffB[i] = (unsigned)(Rb * K + C) * 2u; }
    const size_t kstep = (size_t)(BK * 2);
    const size_t hstepA = (size_t)HALF * lda * 2, hstepB = (size_t)HALF * K * 2;
    const size_t tstepA = 2 * hstepA, tstepB = 2 * hstepB;
    const unsigned ldsw = (unsigned)wid * 1024u;
    const int aoff = lds_byte(wr * 64 + fr, fq * 8), boff = lds_byte(wc * 32 + fr, fq * 8);
#define PG8_SA(b, h) (((b) * 2 + (h)) * HTB)
#define PG8_SB(b, h) ((4 + (b) * 2 + (h)) * HTB)
#define PG8_STAGE(bufoff, gbase, voff) do { _Pragma("unroll") for (int _i = 0; _i < 2; ++_i) \
        __builtin_amdgcn_global_load_lds((const unsigned*)((const char*)(gbase) + (voff)[_i]), (PG8_LAS unsigned*)(lds + (bufoff) + ldsw + _i * 8192), 16, 0, 0); } while (0)
#define PG8_LDA(dst, b, h) do { _Pragma("unroll") for (int m = 0; m < 4; ++m) _Pragma("unroll") for (int k = 0; k < 2; ++k) dst[m][k] = *(const PG8_LAS bf16x8*)(lds + PG8_SA(b, h) + aoff + m * 2048 + k * 1024); } while (0)
#define PG8_LDB(dst, b, h) do { _Pragma("unroll") for (int n = 0; n < 2; ++n) _Pragma("unroll") for (int k = 0; k < 2; ++k) dst[n][k] = *(const PG8_LAS bf16x8*)(lds + PG8_SB(b, h) + boff + n * 2048 + k * 1024); } while (0)
#define PG8_MMA(ai, bj, At, Bt) do { __builtin_amdgcn_s_setprio(1); _Pragma("unroll") for (int m = 0; m < 4; ++m) _Pragma("unroll") for (int n = 0; n < 2; ++n) _Pragma("unroll") for (int k = 0; k < 2; ++k) \
        acc[ai][bj][m][n] = __builtin_amdgcn_mfma_f32_16x16x32_bf16(Bt[n][k], At[m][k], acc[ai][bj][m][n], 0, 0, 0); __builtin_amdgcn_s_setprio(0); } while (0)
#define PG8_WAIT_V(n) asm volatile("s_waitcnt vmcnt(" #n ")" ::: "memory")
#define PG8_WAIT_L(n) asm volatile("s_waitcnt lgkmcnt(" #n ")" ::: "memory")
#define PG8_BAR __builtin_amdgcn_s_barrier()
#define PG8_SCHED __builtin_amdgcn_sched_barrier(0)
    Unit cur, nxt; int ui = 0;
    if (!S.next(0, cur)) return;
    f32x4 acc[2][2][4][2];
#pragma unroll
    for (int a = 0; a < 2; ++a)
#pragma unroll
        for (int b = 0; b < 2; ++b)
#pragma unroll
            for (int m = 0; m < 4; ++m)
#pragma unroll
                for (int n = 0; n < 2; ++n) acc[a][b][m][n] = (f32x4){0.f, 0.f, 0.f, 0.f};
    bf16x8 At[4][2], B0[2][2], B1[2][2];
    const char* cA = (const char*)g.A + (size_t)cur.pm * tstepA; const char* cB = (const char*)g.Bt + (size_t)cur.pn * tstepB;
    S.a_ready(cur);
    if constexpr (SP2) {
        PG8_STAGE(PG8_SB(0, 0), cB, voffB); PG8_STAGE(PG8_SB(0, 1), cB + hstepB, voffB); PG8_STAGE(PG8_SA(0, 0), cA, voffA); PG8_STAGE(PG8_SA(0, 1), cA + hstepA, voffA);
        if (wr == 1) PG8_BAR;
        PG8_WAIT_V(2); PG8_BAR;
        PG8_STAGE(PG8_SB(1, 0), cB + kstep, voffB); PG8_STAGE(PG8_SA(1, 0), cA + kstep, voffA); PG8_STAGE(PG8_SB(1, 1), cB + hstepB + kstep, voffB);
        PG8_WAIT_V(6); PG8_BAR;
    } else {
        PG8_STAGE(PG8_SB(0, 0), cB, voffB); PG8_STAGE(PG8_SA(0, 0), cA, voffA); PG8_STAGE(PG8_SB(0, 1), cB + hstepB, voffB); PG8_STAGE(PG8_SA(0, 1), cA + hstepA, voffA);
        if (wr == 1) PG8_BAR;
        PG8_WAIT_V(4); PG8_BAR;
        PG8_STAGE(PG8_SB(1, 0), cB + kstep, voffB); PG8_STAGE(PG8_SA(1, 0), cA + kstep, voffA); PG8_STAGE(PG8_SB(1, 1), cB + hstepB + kstep, voffB);
        PG8_WAIT_V(6); PG8_BAR;
    }
    for (;;) {
        const bool has_next = S.next(ui + 1, nxt);
        const char* nA = has_next ? (const char*)g.A + (size_t)nxt.pm * tstepA : cA; const char* nB = has_next ? (const char*)g.Bt + (size_t)nxt.pn * tstepB : cB;
        for (int t = 0; t < nt; t += 2) {
            const bool last = (t == nt - 2);
            const char* a1 = cA + (size_t)(t + 1) * kstep;
            const char* a2 = last ? nA : cA + (size_t)(t + 2) * kstep; const char* b2 = last ? nB : cB + (size_t)(t + 2) * kstep;
            const char* a3 = a2 + kstep; const char* b3 = b2 + kstep;
            if (last && has_next) S.a_ready(nxt);
            if constexpr (SP2) {
            PG8_LDB(B0, 0, 0); PG8_LDB(B1, 0, 1); PG8_SCHED; PG8_LDA(At, 0, 0); PG8_STAGE(PG8_SA(1, 1), a1 + hstepA, voffA);
            PG8_WAIT_V(8); PG8_WAIT_L(0); PG8_BAR; PG8_MMA(0, 0, At, B0); PG8_MMA(0, 1, At, B1); PG8_BAR; PG8_SCHED;
            PG8_LDA(At, 0, 1); PG8_STAGE(PG8_SB(0, 0), b2, voffB); PG8_STAGE(PG8_SB(0, 1), b2 + hstepB, voffB); PG8_STAGE(PG8_SA(0, 0), a2, voffA);
            PG8_WAIT_V(8); PG8_WAIT_L(0); PG8_BAR; PG8_MMA(1, 0, At, B0); PG8_MMA(1, 1, At, B1); PG8_BAR; PG8_SCHED;
            PG8_LDB(B0, 1, 0); PG8_LDB(B1, 1, 1); PG8_SCHED; PG8_LDA(At, 1, 0); PG8_STAGE(PG8_SA(0, 1), a2 + hstepA, voffA);
            PG8_WAIT_V(8); PG8_WAIT_L(0); PG8_BAR; PG8_MMA(0, 0, At, B0); PG8_MMA(0, 1, At, B1); PG8_BAR; PG8_SCHED;
            PG8_LDA(At, 1, 1); PG8_STAGE(PG8_SB(1, 0), b3, voffB); PG8_STAGE(PG8_SB(1, 1), b3 + hstepB, voffB); PG8_STAGE(PG8_SA(1, 0), a3, voffA);
            PG8_WAIT_V(8); PG8_WAIT_L(0); PG8_BAR; PG8_MMA(1, 0, At, B0); PG8_MMA(1, 1, At, B1); PG8_BAR; PG8_SCHED;
            } else {
            PG8_LDB(B0, 0, 0); PG8_SCHED; PG8_LDA(At, 0, 0); PG8_STAGE(PG8_SA(1, 1), a1 + hstepA, voffA);
            PG8_WAIT_L(8); PG8_BAR; PG8_WAIT_L(0); PG8_MMA(0, 0, At, B0); PG8_BAR; PG8_SCHED;
            PG8_LDB(B1, 0, 1); PG8_STAGE(PG8_SB(0, 0), b2, voffB);
            PG8_BAR; PG8_WAIT_L(0); PG8_MMA(0, 1, At, B1); PG8_BAR;
            PG8_LDA(At, 0, 1); PG8_STAGE(PG8_SA(0, 0), a2, voffA);
            PG8_BAR; PG8_WAIT_L(0); PG8_MMA(1, 0, At, B0); PG8_BAR; PG8_SCHED;
            PG8_STAGE(PG8_SB(0, 1), b2 + hstepB, voffB);
            PG8_WAIT_V(6); PG8_BAR; PG8_MMA(1, 1, At, B1); PG8_BAR;
            PG8_LDB(B0, 1, 0); PG8_SCHED; PG8_LDA(At, 1, 0); PG8_STAGE(PG8_SA(0, 1), a2 + hstepA, voffA);
            PG8_WAIT_L(8); PG8_BAR; PG8_WAIT_L(0); PG8_MMA(0, 0, At, B0); PG8_BAR; PG8_SCHED;
            PG8_LDB(B1, 1, 1); PG8_STAGE(PG8_SB(1, 0), b3, voffB);
            PG8_BAR; PG8_WAIT_L(0); PG8_MMA(0, 1, At, B1); PG8_BAR;
            PG8_LDA(At, 1, 1); PG8_STAGE(PG8_SA(1, 0), a3, voffA);
            PG8_BAR; PG8_WAIT_L(0); PG8_MMA(1, 0, At, B0); PG8_BAR; PG8_SCHED;
            PG8_STAGE(PG8_SB(1, 1), b3 + hstepB, voffB);
            PG8_WAIT_V(6); PG8_BAR; PG8_MMA(1, 1, At, B1); PG8_BAR;
            }
        }
        if constexpr (ALIGN_EPI) { if (wr == 0) PG8_BAR; }
        if constexpr (!Epi::AFTER_DRAIN) { E(acc, cur, wr, wc, fr, fq); S.done(cur); }
        if (!has_next) break;
#pragma unroll
        for (int a = 0; a < 2; ++a)
#pragma unroll
            for (int b = 0; b < 2; ++b)
#pragma unroll
                for (int m = 0; m < 4; ++m)
#pragma unroll
                    for (int n = 0; n < 2; ++n) acc[a][b][m][n] = (f32x4){0.f, 0.f, 0.f, 0.f};
        cur = nxt; cA = nA; cB = nB; ++ui;
        if constexpr (ALIGN_EPI) { if (wr == 1) PG8_BAR; }
    }
    PG8_WAIT_V(0);
    if constexpr (!ALIGN_EPI) { if (wr == 0) PG8_BAR; }
    PG8_BAR;
    if constexpr (Epi::AFTER_DRAIN) { E.fused(acc, cur, wr, wc, fr, fq, lds, wid, lane); S.done(cur); }
#undef PG8_SA
#undef PG8_SB
#undef PG8_STAGE
#undef PG8_LDA
#undef PG8_LDB
#undef PG8_MMA
#undef PG8_WAIT_V
#undef PG8_WAIT_L
#undef PG8_BAR
#undef PG8_SCHED
}

struct EpiInProj {
    static constexpr bool PERM = true, AFTER_DRAIN = false;
    bf16_t* O; const float* rs; float* ssq_q; float* ssq_kv;
    __device__ __forceinline__ void operator()(const f32x4 (&acc)[2][2][4][2], const Unit& u, int wr, int wc, int fr, int fq) const {
        const int row0 = u.pm * BM + wr * 64 + fr, col0 = u.pn * BM + wc * 32 + 8 * fq;
#pragma unroll
        for (int ai = 0; ai < 2; ++ai)
#pragma unroll
            for (int m = 0; m < 4; ++m) {
                const int row = row0 + ai * HALF + m * 16; const float r = rs[row];
                bf16_t* rowp = O + (size_t)row * NP + col0; float ss[2];
#pragma unroll
                for (int bj = 0; bj < 2; ++bj) { const f32x4 v0 = acc[ai][bj][m][0] * r, v1 = acc[ai][bj][m][1] * r;
                    u32x4 w; w.x = pk2(v0[0], v0[1]); w.y = pk2(v0[2], v0[3]); w.z = pk2(v1[0], v1[1]); w.w = pk2(v1[2], v1[3]);
                    *(u32x4*)(rowp + bj * HALF) = w;
                    ss[bj] = (v0[0] * v0[0] + v0[1] * v0[1]) + (v0[2] * v0[2] + v0[3] * v0[3]) + (v1[0] * v1[0] + v1[1] * v1[1]) + (v1[2] * v1[2] + v1[3] * v1[3]); }
                if (u.pn == 3 || u.pn == 4) {
                    float s = u.pn == 3 ? ss[0] + ss[1] : ss[0];
                    s += __shfl_xor(s, 16); s += __shfl_xor(s, 32);
                    if (fq == 0) ((u.pn == 3 ? ssq_q : ssq_kv) + (size_t)row * 4)[wc] = s;
                }
            }
    }
};
struct EpiF32 {
    static constexpr bool PERM = false, AFTER_DRAIN = false;
    float* O; int ldc;
    __device__ __forceinline__ void operator()(const f32x4 (&acc)[2][2][4][2], const Unit& u, int wr, int wc, int fr, int fq) const {
        const int row0 = u.pm * BM + wr * 64 + fr, col0 = u.pn * BM + wc * 32 + 4 * fq;
#pragma unroll
        for (int ai = 0; ai < 2; ++ai)
#pragma unroll
            for (int m = 0; m < 4; ++m) { float* rowp = O + (size_t)(row0 + ai * HALF + m * 16) * ldc + col0;
#pragma unroll
                for (int bj = 0; bj < 2; ++bj)
#pragma unroll
                    for (int n = 0; n < 2; ++n) *(f32x4*)(rowp + bj * HALF + n * 16) = acc[ai][bj][m][n]; }
    }
};
}

DI void pro_all(const Params& p, int gtid, int gsize) {
    for (int i = gtid; i < 12 * BT_STRIDE; i += gsize) { const int h = i / BT_STRIDE, d = i % BT_STRIDE; ((float*)(p.ws + WS_BTAB))[i] = p.rel_bias[h * 32 + t5_bucket(d)]; }
    for (int i = gtid; i < DEPTH * NP * (D / 8); i += gsize) {
        const int n = i % NP, k8 = (i / NP) % (D / 8), l = i / (NP * (D / 8));
        const int sc = src_col(n);
        float v[8];
#pragma unroll
        for (int j = 0; j < 8; ++j) { const int k = k8 * 8 + j; v[j] = sc >= 0 ? p.w_in[((size_t)l * D + k) * DIN + sc] * p.norm_pre[l * D + k] : 0.f; }
        uint4 w; w.x = pk2(v[0], v[1]); w.y = pk2(v[2], v[3]); w.z = pk2(v[4], v[5]); w.w = pk2(v[6], v[7]);
        *(uint4*)(((bf16_t*)(p.ws + WS_WTIN)) + ((size_t)l * NP + n) * D + k8 * 8) = w;
    }
    for (int i = gtid; i < DEPTH * D * (D / 8); i += gsize) {
        const int n = i % D, k8 = (i / D) % (D / 8), l = i / (D * (D / 8));
        float v[8];
#pragma unroll
        for (int j = 0; j < 8; ++j) v[j] = p.w_out[((size_t)l * D + k8 * 8 + j) * D + n];
        uint4 w; w.x = pk2(v[0], v[1]); w.y = pk2(v[2], v[3]); w.z = pk2(v[4], v[5]); w.w = pk2(v[6], v[7]);
        *(uint4*)(((bf16_t*)(p.ws + WS_WTOUT)) + ((size_t)l * D + n) * D + k8 * 8) = w;
    }
}
DI void pro_xrow(const Params& p, int row, int lane) {
    const float4* xp = (const float4*)(p.x_in + (size_t)row * D);
    float s = 0.f;
#pragma unroll
    for (int i = 0; i < 4; ++i) { const float4 v = xp[lane + 64 * i]; s += v.x * v.x + v.y * v.y + v.z * v.z + v.w * v.w;
        uint2 w; w.x = pk2(v.x, v.y); w.y = pk2(v.z, v.w); ((uint2*)(((bf16_t*)(p.ws + WS_XB)) + (size_t)row * D))[lane + 64 * i] = w; }
    for (int o = 32; o > 0; o >>= 1) s += __shfl_xor(s, o);
    if (lane == 0) ((float*)(p.ws + WS_RS))[row] = rsqrtf(s * (1.0f / D) + 1e-6f);
}
DI void post_row(const Params& p, int layer, int row, int lane) {
    const float* x = (layer == 0 ? p.x_in : p.xout) + (size_t)row * D;
    const float* y = ((float*)(p.ws + WS_P)) + (size_t)row * D;
    const float* g = p.norm_post + layer * D;
    float4 yv[4]; float s = 0.f;
#pragma unroll
    for (int i = 0; i < 4; ++i) { yv[i] = ((const float4*)y)[lane + 64 * i]; s += yv[i].x * yv[i].x + yv[i].y * yv[i].y + yv[i].z * yv[i].z + yv[i].w * yv[i].w; }
    for (int o = 32; o > 0; o >>= 1) s += __shfl_xor(s, o);
    const float r = rsqrtf(s * (1.f / D) + 1e-6f);
    float s2 = 0.f;
#pragma unroll
    for (int i = 0; i < 4; ++i) {
        const float4 xv = ((const float4*)x)[lane + 64 * i], gv = ((const float4*)g)[lane + 64 * i];
        float4 o; o.x = xv.x + yv[i].x * r * gv.x; o.y = xv.y + yv[i].y * r * gv.y; o.z = xv.z + yv[i].z * r * gv.z; o.w = xv.w + yv[i].w * r * gv.w;
        ((float4*)(p.xout + (size_t)row * D))[lane + 64 * i] = o;
        uint2 w; w.x = pk2(o.x, o.y); w.y = pk2(o.z, o.w); ((uint2*)(((bf16_t*)(p.ws + WS_XB)) + (size_t)row * D))[lane + 64 * i] = w;
        s2 += o.x * o.x + o.y * o.y + o.z * o.z + o.w * o.w;
    }
    for (int o = 32; o > 0; o >>= 1) s2 += __shfl_xor(s2, o);
    if (lane == 0) ((float*)(p.ws + WS_RS))[row] = rsqrtf(s2 * (1.f / D) + 1e-6f);
}

DI void b_mla_up(const Params& p, int T512, int layer, int vb, char* smem) {
    float (*cq)[256] = (float (*)[256])smem;
    float (*ckv)[128] = (float (*)[128])(smem + 8192);
    float (*qb)[384] = (float (*)[384])(smem + 8192 + 4096);
    float (*red)[2] = (float (*)[2])(smem + 8192 + 4096 + 12288);
    const int tid = T512 & 255, tok0 = vb * 8;
    {
        const int tk = tid >> 5, l32 = tid & 31;
        float s1 = 0.f, s2 = 0.f;
        for (int k = l32; k < 256; k += 32) { float v = bf2f(((bf16_t*)(p.ws + WS_P))[(size_t)(tok0 + tk) * NP + C_BCQ + k]); cq[tk][k] = v; s1 += v * v; }
        for (int k = l32; k < 128; k += 32) { float v = bf2f(((bf16_t*)(p.ws + WS_P))[(size_t)(tok0 + tk) * NP + C_BCKV + k]); ckv[tk][k] = v; s2 += v * v; }
        for (int o = 16; o > 0; o >>= 1) { s1 += __shfl_xor(s1, o); s2 += __shfl_xor(s2, o); }
        if (l32 == 0) { const float4 a = ((const float4*)(p.ws + WS_SSQQ))[tok0 + tk], bq = ((const float4*)(p.ws + WS_SSQKV))[tok0 + tk];
            red[tk][0] = rsqrtf(((a.x + a.y) + (a.z + a.w)) * (1.f / 256.f) + 1e-6f); red[tk][1] = rsqrtf(((bq.x + bq.y) + (bq.z + bq.w)) * (1.f / 128.f) + 1e-6f); }
    }
    __syncthreads();
    {
        const int tk = tid >> 5, l32 = tid & 31;
        for (int k = l32; k < 256; k += 32) cq[tk][k] *= red[tk][0] * p.q_norm[layer * 256 + k];
        for (int k = l32; k < 128; k += 32) ckv[tk][k] *= red[tk][1] * p.kv_norm[layer * 128 + k];
    }
    __syncthreads();
    const float* wq = p.w_uq + (size_t)layer * 256 * 384;
    for (int j = tid; j < 384; j += 256) {
        float acc[8] = {0, 0, 0, 0, 0, 0, 0, 0};
        for (int k = 0; k < 256; ++k) { const float w = wq[k * 384 + j];
#pragma unroll
            for (int tk = 0; tk < 8; ++tk) acc[tk] += cq[tk][k] * w; }
#pragma unroll
        for (int tk = 0; tk < 8; ++tk) qb[tk][j] = acc[tk];
    }
    const float* wkv = p.w_ukv + (size_t)layer * 128 * 512;
    for (int j = tid; j < 512; j += 256) {
        float acc[8] = {0, 0, 0, 0, 0, 0, 0, 0};
        for (int k = 0; k < 128; ++k) { const float w = wkv[k * 512 + j];
#pragma unroll
            for (int tk = 0; tk < 8; ++tk) acc[tk] += ckv[tk][k] * w; }
        const int h = j >> 7, e = j & 127;
#pragma unroll
        for (int tk = 0; tk < 8; ++tk) {
            if (e < 64) ((bf16_t*)(p.ws + WS_KM))[(size_t)(tok0 + tk) * 384 + h * 96 + e] = f2bf(acc[tk]);
            else ((bf16_t*)(p.ws + WS_VM))[(size_t)(tok0 + tk) * 256 + h * 64 + (e - 64)] = f2bf(acc[tk]);
        }
    }
    __syncthreads();
    for (int idx = tid; idx < 8 * 4 * 64; idx += 256) {
        const int tk = idx >> 8, h = (idx >> 6) & 3, e = idx & 63;
        ((bf16_t*)(p.ws + WS_QM))[(size_t)(tok0 + tk) * 384 + h * 96 + e] = f2bf(qb[tk][h * 96 + e]);
    }
    for (int idx = tid; idx < 8 * 5 * 16; idx += 256) {
        const int tk = idx / 80, r = idx % 80, h = r >> 4, i = r & 15;
        const int tok = tok0 + tk, pos = tok % T;
        const float inv = powf(10000.0f, -(float)i / 16.0f);
        const float ang = (float)pos * inv;
        const float cs = cosf(ang), sn = sinf(ang);
        if (h < 4) {
            const float x1 = qb[tk][h * 96 + 64 + i], x2 = qb[tk][h * 96 + 80 + i];
            ((bf16_t*)(p.ws + WS_QM))[(size_t)tok * 384 + h * 96 + 64 + i] = f2bf(x1 * cs - x2 * sn);
            ((bf16_t*)(p.ws + WS_QM))[(size_t)tok * 384 + h * 96 + 80 + i] = f2bf(x2 * cs + x1 * sn);
        } else {
            const float x1 = bf2f(((bf16_t*)(p.ws + WS_P))[(size_t)tok * NP + C_BKR + i]), x2 = bf2f(((bf16_t*)(p.ws + WS_P))[(size_t)tok * NP + C_BKR + 16 + i]);
            const bf16_t o1 = f2bf(x1 * cs - x2 * sn), o2 = f2bf(x2 * cs + x1 * sn);
            for (int hh = 0; hh < 4; ++hh) { ((bf16_t*)(p.ws + WS_KM))[(size_t)tok * 384 + hh * 96 + 64 + i] = o1; ((bf16_t*)(p.ws + WS_KM))[(size_t)tok * 384 + hh * 96 + 80 + i] = o2; }
        }
    }
}

DI void b_compress(const Params& p, int T512, int layer, int bx, int which, int b, char* smem) {
    float (*tok)[64] = (float (*)[64])smem;
    float (*pe)[64] = (float (*)[64])(smem + 144 * 64 * 4);
    float (*hid)[128] = (float (*)[128])(smem + 144 * 64 * 4 + 32 * 64 * 4);
    const int tid = T512 & 255, c0 = bx * 8;
    const int col = which == 0 ? C_KCMP : C_VCMP;
    for (int idx = tid; idx < 144 * 64; idx += 256) {
        const int r = idx >> 6, d = idx & 63, t = c0 * 16 + r;
        tok[r][d] = t < T ? bf2f(((bf16_t*)(p.ws + WS_P))[(size_t)(b * T + t) * NP + col + d]) : 0.f;
    }
    const float* pep = p.cmp_pos + ((size_t)layer * 2 + which) * 32 * 64;
    for (int idx = tid; idx < 32 * 64; idx += 256) pe[idx >> 6][idx & 63] = pep[idx];
    __syncthreads();
    const int j = tid & 127, half = tid >> 7;
    const float* w1 = p.cmp_w1 + ((size_t)layer * 2 + which) * 2048 * 128;
    float acc[4] = {0, 0, 0, 0};
    for (int i = 0; i < 32; ++i)
        for (int d = 0; d < 64; ++d) {
            const float w = w1[(size_t)(i * 64 + d) * 128 + j], pp = pe[i][d];
#pragma unroll
            for (int cc = 0; cc < 4; ++cc) acc[cc] += (tok[(half * 4 + cc) * 16 + i][d] + pp) * w;
        }
#pragma unroll
    for (int cc = 0; cc < 4; ++cc) { const float a = acc[cc]; hid[half * 4 + cc][j] = a / (1.f + expf(-a)); }
    __syncthreads();
    const float* w2 = p.cmp_w2 + ((size_t)layer * 2 + which) * 128 * 64;
    float* outp = which == 0 ? ((float*)(p.ws + WS_KC)) : ((float*)(p.ws + WS_VC));
    for (int idx = tid; idx < 8 * 64; idx += 256) {
        const int cc = idx >> 6, d = idx & 63, c = c0 + cc;
        float s = 0.f;
        for (int jj = 0; jj < 128; ++jj) s += hid[cc][jj] * w2[jj * 64 + d];
        if (c < 255) outp[((size_t)b * 256 + c) * 64 + d] = s;
    }
}

DI void b_cmp_attn(const Params& p, int T512, int bx, int b, char* smem) {
    float (*imp)[65] = (float (*)[65])smem;
    const int tid = T512 & 255, tl = tid >> 2, h = tid & 3;
    const int t0 = bx * 64, t = t0 + tl;
    const size_t tok = (size_t)b * T + t;
    float q[64];
    {
        const uint4* qp = (const uint4*)(((bf16_t*)(p.ws + WS_P)) + tok * NP + C_AQ + h * 64);
#pragma unroll
        for (int c = 0; c < 8; ++c) { const uint4 w = qp[c];
            q[c * 8 + 0] = bflo(w.x); q[c * 8 + 1] = bfhi(w.x); q[c * 8 + 2] = bflo(w.y); q[c * 8 + 3] = bfhi(w.y);
            q[c * 8 + 4] = bflo(w.z); q[c * 8 + 5] = bfhi(w.z); q[c * 8 + 6] = bflo(w.w); q[c * 8 + 7] = bfhi(w.w); }
    }
    const int nv = t >= 31 ? min(255, (t - 31) / 16 + 1) : 0;
    const int nvmax = (t0 + 63 >= 31) ? min(255, (t0 + 63 - 31) / 16 + 1) : 0;
    const float* kcb = ((float*)(p.ws + WS_KC)) + (size_t)b * 256 * 64;
    const float* vcb = ((float*)(p.ws + WS_VC)) + (size_t)b * 256 * 64;
    const float* bt = ((float*)(p.ws + WS_BTAB)) + h * BT_STRIDE;
    float m = -1e30f, l = 0.f;
    for (int c = 0; c < nvmax; ++c) {
        const float4* kp = (const float4*)(kcb + c * 64);
        float s = 0.f;
#pragma unroll
        for (int d4 = 0; d4 < 16; ++d4) { const float4 kv = kp[d4]; s += q[d4 * 4] * kv.x + q[d4 * 4 + 1] * kv.y + q[d4 * 4 + 2] * kv.z + q[d4 * 4 + 3] * kv.w; }
        if (c < nv) {
            const int dist = t - (16 * c + 31);
            s = s * 0.125f + bt[min(dist, 512)];
            const float mn = fmaxf(m, s);
            l = l * expf(m - mn) + expf(s - mn); m = mn;
        }
    }
    const float invl = nv > 0 ? 1.f / l : 0.f;
    float o[64];
#pragma unroll
    for (int d = 0; d < 64; ++d) o[d] = 0.f;
    float prev3 = 0.f;
    for (int s4 = 0; s4 < 64; ++s4) {
        float pc[4];
#pragma unroll
        for (int r = 0; r < 4; ++r) {
            const int c = s4 * 4 + r;
            float pr = 0.f;
            if (c < nvmax) {
                const float4* kp = (const float4*)(kcb + c * 64);
                float s = 0.f;
#pragma unroll
                for (int d4 = 0; d4 < 16; ++d4) { const float4 kv = kp[d4]; s += q[d4 * 4] * kv.x + q[d4 * 4 + 1] * kv.y + q[d4 * 4 + 2] * kv.z + q[d4 * 4 + 3] * kv.w; }
                if (c < nv) {
                    const int dist = t - (16 * c + 31);
                    s = s * 0.125f + bt[min(dist, 512)];
                    pr = expf(s - m) * invl;
                    const float4* vp = (const float4*)(vcb + c * 64);
#pragma unroll
                    for (int d4 = 0; d4 < 16; ++d4) { const float4 vv = vp[d4]; o[d4 * 4] += pr * vv.x; o[d4 * 4 + 1] += pr * vv.y; o[d4 * 4 + 2] += pr * vv.z; o[d4 * 4 + 3] += pr * vv.w; }
                }
            }
            pc[r] = pr;
        }
        float v = 2.f * (pc[0] + pc[1] + pc[2]) + pc[3] + prev3;
        prev3 = pc[3];
        v += __shfl_xor(v, 1); v += __shfl_xor(v, 2);
        if (h == 0) imp[tl][s4] = v;
    }
    {
        const float gl = bf2f(((bf16_t*)(p.ws + WS_P))[tok * NP + C_AG + h * 3 + 0]);
        const float gt = 1.f / (1.f + expf(-gl));
        float* op = ((float*)(p.ws + WS_OA)) + tok * 256 + h * 64;
#pragma unroll
        for (int d4 = 0; d4 < 16; ++d4) *(float4*)(op + d4 * 4) = make_float4(gt * o[d4 * 4], gt * o[d4 * 4 + 1], gt * o[d4 * 4 + 2], gt * o[d4 * 4 + 3]);
    }
    __syncthreads();
    if (h == 0) {
        const int cur = t >> 6;
        unsigned long long mask;
        if (cur + 1 <= 16) mask = (cur == 63) ? ~0ull : ((1ull << (cur + 1)) - 1ull);
        else {
            mask = 1ull | (1ull << cur) | (1ull << (cur - 1));
            for (int it = 0; it < 13; ++it) {
                float best = -3e38f; int bi = -1;
                for (int s = 1; s <= cur - 2; ++s) { const float v = imp[tl][s]; if (!((mask >> s) & 1ull) && v > best) { best = v; bi = s; } }
                if (bi >= 0) mask |= 1ull << bi;
            }
        }
        ((unsigned long long*)(p.ws + WS_SEL))[tok] = mask;
    }
}

template <int MODE>
DI void b_attn(const Params& p, int T512, int layer, int bx, int b, int bz) {
    constexpr int DK = MODE == 0 ? 96 : 64;
    const int tid = T512 & 255, tl = tid & 63, hh = tid >> 6;
    const int t0 = bx * 64, t = t0 + tl;
    const int h = (MODE == 2 ? bz * 4 : 0) + hh;
    const size_t tok = (size_t)b * T + t;
    const bf16_t *Kb, *Vb, *qp; int kst, vst; float scale; const float* bt = nullptr; int W;
    if (MODE == 0) { Kb = ((bf16_t*)(p.ws + WS_KM)) + (size_t)b * T * 384 + h * 96; Vb = ((bf16_t*)(p.ws + WS_VM)) + (size_t)b * T * 256 + h * 64; kst = 384; vst = 256; qp = ((bf16_t*)(p.ws + WS_QM)) + tok * 384 + h * 96; scale = 0.10206207261596577f; W = 1 << 30; }
    if (MODE == 1) { Kb = ((bf16_t*)(p.ws + WS_P)) + (size_t)b * T * NP + C_KWIN; Vb = ((bf16_t*)(p.ws + WS_P)) + (size_t)b * T * NP + C_VWIN; kst = NP; vst = NP; qp = ((bf16_t*)(p.ws + WS_P)) + tok * NP + C_AQ + h * 64; scale = 0.125f; bt = ((float*)(p.ws + WS_BTAB)) + h * BT_STRIDE; W = 512; }
    if (MODE == 2) { Kb = ((bf16_t*)(p.ws + WS_P)) + (size_t)b * T * NP + C_CK; Vb = ((bf16_t*)(p.ws + WS_P)) + (size_t)b * T * NP + C_CV; kst = NP; vst = NP; qp = ((bf16_t*)(p.ws + WS_P)) + tok * NP + C_CQ + h * 64; scale = 0.125f; bt = ((float*)(p.ws + WS_BTAB)) + (4 + h) * BT_STRIDE; W = 128; }
    if (MODE == 3) { Kb = ((bf16_t*)(p.ws + WS_P)) + (size_t)b * T * NP + C_KSLC; Vb = ((bf16_t*)(p.ws + WS_P)) + (size_t)b * T * NP + C_VSLC; kst = NP; vst = NP; qp = ((bf16_t*)(p.ws + WS_P)) + tok * NP + C_AQ + h * 64; scale = 0.125f; bt = ((float*)(p.ws + WS_BTAB)) + h * BT_STRIDE; W = 1 << 30; }
    uint4 q[DK / 8];
#pragma unroll
    for (int c = 0; c < DK / 8; ++c) q[c] = ((const uint4*)qp)[c];
    unsigned long long mask = ~0ull;
    if (MODE == 3) mask = ((unsigned long long*)(p.ws + WS_SEL))[tok];
    const int jlo = (MODE == 1 || MODE == 2) ? max(0, t0 - (W - 1)) : 0;
    const int jhi = t0 + 63;
    for (int dh = 0; dh < 2; ++dh) {
    float o[32];
#pragma unroll
    for (int d = 0; d < 32; ++d) o[d] = 0.f;
    float m = -1e30f, l = 0.f;
    for (int j = jlo; j <= jhi; ++j) {
        if (MODE == 3) { if ((j & 63) == 0 && !__any((int)((mask >> (j >> 6)) & 1ull))) { j += 63; continue; } }
        const uint4* kp = (const uint4*)(Kb + (size_t)j * kst);
        float s = 0.f;
#pragma unroll
        for (int c = 0; c < DK / 8; ++c) { const uint4 w = kp[c]; const uint4 qq = q[c];
            s += bflo(qq.x) * bflo(w.x) + bfhi(qq.x) * bfhi(w.x) + bflo(qq.y) * bflo(w.y) + bfhi(qq.y) * bfhi(w.y)
               + bflo(qq.z) * bflo(w.z) + bfhi(qq.z) * bfhi(w.z) + bflo(qq.w) * bflo(w.w) + bfhi(qq.w) * bfhi(w.w); }
        const int dist = t - j;
        bool valid = dist >= 0 && dist < W;
        if (MODE == 3) valid = valid && ((mask >> (j >> 6)) & 1ull);
        if (valid) {
            s *= scale;
            if (MODE != 0) s += bt[min(dist, 512)];
            const float mn = fmaxf(m, s), a = expf(m - mn), pr = expf(s - mn);
            l = l * a + pr; m = mn;
            const uint4* vp = (const uint4*)(Vb + (size_t)j * vst + dh * 32);
#pragma unroll
            for (int c = 0; c < 4; ++c) { const uint4 w = vp[c];
                o[c * 8 + 0] = o[c * 8 + 0] * a + pr * bflo(w.x); o[c * 8 + 1] = o[c * 8 + 1] * a + pr * bfhi(w.x);
                o[c * 8 + 2] = o[c * 8 + 2] * a + pr * bflo(w.y); o[c * 8 + 3] = o[c * 8 + 3] * a + pr * bfhi(w.y);
                o[c * 8 + 4] = o[c * 8 + 4] * a + pr * bflo(w.z); o[c * 8 + 5] = o[c * 8 + 5] * a + pr * bfhi(w.z);
                o[c * 8 + 6] = o[c * 8 + 6] * a + pr * bflo(w.w); o[c * 8 + 7] = o[c * 8 + 7] * a + pr * bfhi(w.w); }
        }
    }
    if (MODE == 2) { const float sk = p.sinks[layer * 8 + h]; const float mn = fmaxf(m, sk); const float a = expf(m - mn); l = l * a + expf(sk - mn);
#pragma unroll
        for (int d = 0; d < 32; ++d) o[d] *= a; }
    const float invl = 1.f / l;
    if (MODE == 3) {
        const float gl = bf2f(((bf16_t*)(p.ws + WS_P))[tok * NP + C_AG + h * 3 + 1]);
        const float gt = invl / (1.f + expf(-gl));
        float* op = ((float*)(p.ws + WS_OA)) + tok * 256 + h * 64 + dh * 32;
#pragma unroll
        for (int d = 0; d < 32; ++d) op[d] += gt * o[d];
    } else {
        float gt = invl; int mcol;
        if (MODE == 1) { const float gl = bf2f(((bf16_t*)(p.ws + WS_P))[tok * NP + C_AG + h * 3 + 2]); gt = invl / (1.f + expf(-gl)); mcol = h * 64; }
        else if (MODE == 0) mcol = 256 + h * 64; else mcol = 512 + h * 64;
        mcol += dh * 32;
        const bf16_t* zp = ((bf16_t*)(p.ws + WS_P)) + tok * NP + C_Z + mcol;
        bf16_t* mp = ((bf16_t*)(p.ws + WS_MIX)) + tok * 1024 + mcol;
        const float* op = ((float*)(p.ws + WS_OA)) + tok * 256 + h * 64 + dh * 32;
#pragma unroll
        for (int d = 0; d < 32; ++d) {
            float v = gt * o[d]; if (MODE == 1) v += op[d];
            const float z = bf2f(zp[d]);
            mp[d] = f2bf(v * z / (1.f + expf(-z)));
        }
    }
    }
}

constexpr int SMEM_BYTES = pg8::STAGE_BYTES;
constexpr int VSMEM = 49152;

__global__ void __launch_bounds__(512, 2) mega(Params p0) {
    extern __shared__ __attribute__((aligned(16))) char smem[];
    cg::grid_group grid = cg::this_grid();
    for (int ph = 0; ph < 1 + 6 * DEPTH; ++ph) {
        int ph_ = ph; asm volatile("" : "+s"(ph_));
        int t_ = threadIdx.x; asm volatile("" : "+v"(t_));
        Params p = p0;
        asm volatile("" : "+s"(p.ws), "+s"(p.xout));
#pragma unroll
        for (int i_ = 0; i_ < 14; ++i_) asm volatile("" : "+s"(p.in[i_]));
        const int G = gridDim.x, bid = blockIdx.x, NGW = G * 8;
        const int l = (ph_ - 1) / 6, k = ph_ == 0 ? -1 : (ph_ - 1) % 6;
        const int vh_ = t_ >> 8; char* vsm_ = smem + vh_ * VSMEM;
        if (k == -1) {
            pro_all(p, bid * 512 + t_, G * 512);
            for (int row = bid * 8 + (t_ >> 6); row < NTOK; row += NGW) pro_xrow(p, row, t_ & 63);
        } else if (k == 0) {
            pg8::Gemm g{((bf16_t*)(p.ws + WS_XB)), ((bf16_t*)(p.ws + WS_WTIN)) + (size_t)l * NP * D, NTOK, NP, D, D};
            pg8::StaticOrder S; S.init(NTOK, NP, G, bid);
            pg8::EpiInProj E{((bf16_t*)(p.ws + WS_P)), ((float*)(p.ws + WS_RS)), ((float*)(p.ws + WS_SSQQ)), ((float*)(p.ws + WS_SSQKV))};
            pg8::gemm_phase<pg8::EpiInProj, pg8::StaticOrder, true, true>((PG8_LAS unsigned char*)smem, g, S, E);
        } else if (k == 1) {
            for (int vb = 2 * bid + vh_; vb < 256 + NTOK / 8; vb += 2 * G) {
                if (vb < 256) b_compress(p, t_, l, vb & 31, (vb >> 5) & 1, vb >> 6, vsm_); else b_mla_up(p, t_, l, vb - 256, vsm_);
                __syncthreads();
            }
        } else if (k == 2) {
            for (int vb = 2 * bid + vh_; vb < 256 + 512; vb += 2 * G) {
                if (vb < 256) { b_cmp_attn(p, t_, vb & 63, vb >> 6, vsm_); }
                else { const int u = vb - 256; b_attn<2>(p, t_, l, u & 63, (u >> 6) & 3, u >> 8); }
            }
        } else if (k == 3) {
            for (int vb = 2 * bid + vh_; vb < 512; vb += 2 * G) {
                const int u = vb >> 1, tile = 63 - (u >> 2), b = u & 3;
                if (vb & 1) { b_attn<3>(p, t_, l, tile, b, 0); b_attn<1>(p, t_, l, tile, b, 0); }
                else b_attn<0>(p, t_, l, tile, b, 0);
            }
        } else if (k == 4) {
            pg8::Gemm g{((bf16_t*)(p.ws + WS_MIX)), ((bf16_t*)(p.ws + WS_WTOUT)) + (size_t)l * D * D, NTOK, D, D, D};
            pg8::StaticOrder S; S.init(NTOK, D, G, bid);
            pg8::EpiF32 E{((float*)(p.ws + WS_P)), D};
            pg8::gemm_phase<pg8::EpiF32, pg8::StaticOrder, true, true>((PG8_LAS unsigned char*)smem, g, S, E);
        } else {
            for (int row = bid * 8 + (t_ >> 6); row < NTOK; row += NGW) post_row(p, l, row, t_ & 63);
        }
        grid.sync();
    }
}

extern "C" void kernel_launch(void* const* d_in, const int* in_sizes, int n_in, void* d_out, int out_size, void* d_ws, size_t ws_size, hipStream_t stream) {
    Params p{};
    for (int i = 0; i < 14; ++i) p.in[i] = (const float*)d_in[i];
    p.xout = (float*)d_out; p.ws = (char*)d_ws;
    const size_t off = WS_END;
    static int grid_blocks = 0;
    if (!grid_blocks) {
        int dev = 0, cus = 0, per_cu = 0;
        (void)hipGetDevice(&dev);
        (void)hipDeviceGetAttribute(&cus, hipDeviceAttributeMultiprocessorCount, dev);
        (void)hipFuncSetAttribute((const void*)mega, hipFuncAttributeMaxDynamicSharedMemorySize, SMEM_BYTES);
        (void)hipOccupancyMaxActiveBlocksPerMultiprocessor(&per_cu, (const void*)mega, 512, SMEM_BYTES);
        if (per_cu < 1) fprintf(stderr, "occupancy query says %d blocks per CU\n", per_cu);
        grid_blocks = cus;
        if (off > ws_size) fprintf(stderr, "workspace too small: need %zu have %zu\n", off, ws_size);
    }
    void* args[] = {&p};
    hipError_t e = hipLaunchCooperativeKernel((void*)mega, dim3(grid_blocks), dim3(512), args, SMEM_BYTES, stream);
    if (e != hipSuccess) fprintf(stderr, "cooperative launch failed: %s (grid %d)\n", hipGetErrorString(e), grid_blocks);
}
```

```cpp
#include <hip/hip_runtime.h>
#include <hip/hip_cooperative_groups.h>
#include <stdint.h>
#include <cstdio>
namespace cg = cooperative_groups;

typedef unsigned short bf16_t;
#define DI __device__ __forceinline__

DI float bf2f(bf16_t v) { return __uint_as_float(((unsigned)v) << 16); }
DI bf16_t f2bf(float f) { unsigned u = __float_as_uint(f); u += 0x7fffu + ((u >> 16) & 1u); return (bf16_t)(u >> 16); }
DI float bflo(unsigned w) { return __uint_as_float(w << 16); }
DI float bfhi(unsigned w) { return __uint_as_float(w & 0xffff0000u); }
DI unsigned pk2(float lo, float hi) { return (unsigned)f2bf(lo) | ((unsigned)f2bf(hi) << 16); }

constexpr int NB = 4, T = 4096, D = 1024, NTOK = NB * T, DEPTH = 4, DIN = 2732, NP = 2816;
constexpr int C_AQ = 0, C_KCMP = 256, C_VCMP = 320, C_KSLC = 384, C_VSLC = 448, C_KWIN = 512, C_VWIN = 576, C_CK = 640, C_CV = 704;
constexpr int C_BCQ = 768, C_BCKV = 1024, C_BKR = 1152, C_AG = 1184, C_CQ = 1280, C_Z = 1792;
constexpr int BT_STRIDE = 520;

__host__ __device__ inline int src_col(int n) {
    if (n < 640) return n;
    if (n < 768) return 1580 + (n - 640);
    if (n < 1024) return 652 + (n - 768);
    if (n < 1152) return 908 + (n - 1024);
    if (n < 1184) return 1036 + (n - 1152);
    if (n < 1196) return 640 + (n - 1184);
    if (n < 1280) return -1;
    if (n < 1792) return 1068 + (n - 1280);
    return 1708 + (n - 1792);
}

DI int t5_bucket(int d) {
    if (d < 16) return d < 0 ? 0 : d;
    int b = 16;
    b += d >= 20; b += d >= 25; b += d >= 31; b += d >= 39; b += d >= 48; b += d >= 59; b += d >= 73; b += d >= 91;
    b += d >= 113; b += d >= 140; b += d >= 174; b += d >= 216; b += d >= 268; b += d >= 332; b += d >= 413;
    return b;
}

constexpr size_t al256(size_t x) { return (x + 255) & ~(size_t)255; }
constexpr size_t WS_P = 0;
constexpr size_t WS_XB = WS_P + al256((size_t)NTOK * NP * 2 + 65536);
constexpr size_t WS_WTIN = WS_XB + al256((size_t)NTOK * D * 2);
constexpr size_t WS_WTOUT = WS_WTIN + al256((size_t)DEPTH * NP * D * 2);
constexpr size_t WS_QM = WS_WTOUT + al256((size_t)DEPTH * D * D * 2);
constexpr size_t WS_KM = WS_QM + al256((size_t)NTOK * 384 * 2);
constexpr size_t WS_VM = WS_KM + al256((size_t)NTOK * 384 * 2);
constexpr size_t WS_MIX = WS_VM + al256((size_t)NTOK * 256 * 2);
constexpr size_t WS_OA = WS_MIX + al256((size_t)NTOK * 1024 * 2);
constexpr size_t WS_RS = WS_OA + al256((size_t)NTOK * 256 * 4);
constexpr size_t WS_SSQQ = WS_RS + al256((size_t)NTOK * 4);
constexpr size_t WS_SSQKV = WS_SSQQ + al256((size_t)NTOK * 16);
constexpr size_t WS_KC = WS_SSQKV + al256((size_t)NTOK * 16);
constexpr size_t WS_VC = WS_KC + al256((size_t)NB * 256 * 64 * 4);
constexpr size_t WS_SEL = WS_VC + al256((size_t)NB * 256 * 64 * 4);
constexpr size_t WS_BTAB = WS_SEL + al256((size_t)NTOK * 8);
constexpr size_t WS_END = WS_BTAB + al256((size_t)12 * BT_STRIDE * 4);

struct Params {
    const float* in[14]; float* xout; char* ws;
#define PF(name, idx) DI const float* name() const { return in[idx]; }
    PF(x_in_, 0) PF(w_in_, 1) PF(w_out_, 2) PF(norm_pre_, 3) PF(norm_post_, 4) PF(cmp_pos_, 5) PF(cmp_w1_, 6) PF(cmp_w2_, 7) PF(q_norm_, 8) PF(w_uq_, 9) PF(kv_norm_, 10) PF(w_ukv_, 11) PF(sinks_, 12) PF(rel_bias_, 13)
#undef PF
};
#define x_in x_in_()
#define w_in w_in_()
#define w_out w_out_()
#define norm_pre norm_pre_()
#define norm_post norm_post_()
#define cmp_pos cmp_pos_()
#define cmp_w1 cmp_w1_()
#define cmp_w2 cmp_w2_()
#define q_norm q_norm_()
#define w_uq w_uq_()
#define kv_norm kv_norm_()
#define w_ukv w_ukv_()
#define sinks sinks_()
#define rel_bias rel_bias_()

namespace pg8 {
#define PG8_LAS __attribute__((address_space(3)))
typedef short bf16x8 __attribute__((ext_vector_type(8)));
typedef float f32x4 __attribute__((ext_vector_type(4)));
typedef unsigned u32x4 __attribute__((ext_vector_type(4)));
constexpr int BM = 256, BK = 64, HALF = 128, HTB = HALF * BK * 2  , STAGE_BYTES = 8 * HTB, NXCD = 8, WGM = 8;

__host__ __device__ __forceinline__ int lds_byte(int r, int c) { const int st = (r >> 4) * 2 + (c >> 5), rr = r & 15, cc = c & 31, ob = rr * 64 + cc * 2; return st * 1024 + (ob ^ (((ob >> 9) & 1) << 5)); }
__host__ __device__ __forceinline__ void stage_rc(int b, int& R, int& C) { const int st = b / 1024, sb = b % 1024, swz = sb ^ (((sb >> 9) & 1) << 5); R = (st >> 1) * 16 + swz / 64; C = (st & 1) * 32 + (swz % 64) / 2; }
__host__ __device__ __forceinline__ int perm32(int rho) { const int n = rho >> 4, i = rho & 15; return 8 * (i >> 2) + 4 * n + (i & 3); }

struct Unit { int pm, pn; };
struct Gemm { const bf16_t* A; const bf16_t* Bt; int M, N, K, lda; };

struct StaticOrder {
    int nM, nN, nwg, G, c;
    __host__ __device__ void init(int M, int N, int G_, int c_) { nM = M / BM; nN = N / BM; nwg = nM * nN; G = G_; c = c_; }
    __host__ __device__ bool next(int i, Unit& u) const {
        const long L = (long)i * G + c; if (L >= nwg) return false;
        int wgid = (int)L; { const int q = nwg / NXCD, r = nwg % NXCD, xcd = wgid % NXCD, off = wgid / NXCD; wgid = (xcd < r ? xcd * (q + 1) : r * (q + 1) + (xcd - r) * q) + off; }
        const int nig = WGM * nN, gid = wgid / nig, fm = gid * WGM, gsz = (nM - fm) < WGM ? (nM - fm) : WGM;
        u.pm = fm + ((wgid % nig) % gsz); u.pn = (wgid % nig) / gsz; return true;
    }
    __device__ __forceinline__ void a_ready(const Unit&) const {}
    __device__ __forceinline__ void done(const Unit&) const {}
};

template <class Epi, class Sched, bool ALIGN_EPI = false, bool SP2 = false>
__device__ __forceinline__ void gemm_phase(const int tid, PG8_LAS unsigned char* lds, const Gemm g, const Sched& S, const Epi& E) {
    const int wid = __builtin_amdgcn_readfirstlane(tid >> 6), lane = tid & 63, wr = wid >> 2, wc = wid & 3, fr = lane & 15, fq = lane >> 4;
    const int K = g.K, nt = K / BK, lda = g.lda;
    unsigned voffA, voffB;
    { int R, C; stage_rc(tid * 16, R, C); const int Rb = Epi::PERM ? ((R & ~31) + perm32(R & 31)) : R;
      voffA = (unsigned)(R * lda + C) * 2u; voffB = (unsigned)(Rb * K + C) * 2u; }
    const size_t pvoffA = (size_t)64 * lda * 2, pvoffB = (size_t)64 * K * 2;
    const size_t kstep = (size_t)(BK * 2);
    const size_t hstepA = (size_t)HALF * lda * 2, hstepB = (size_t)HALF * K * 2;
    const size_t tstepA = 2 * hstepA, tstepB = 2 * hstepB;
    const unsigned ldsw = (unsigned)wid * 1024u;
    const int aoff = lds_byte(wr * 64 + fr, fq * 8), boff = lds_byte(wc * 32 + fr, fq * 8);
#define PG8_SA(b, h) (((b) * 2 + (h)) * HTB)
#define PG8_SB(b, h) ((4 + (b) * 2 + (h)) * HTB)
#define PG8_STAGE(bufoff, gbase, voff) do { _Pragma("unroll") for (int _i = 0; _i < 2; ++_i) \
        __builtin_amdgcn_global_load_lds((const unsigned*)((const char*)(gbase) + _i * p##voff + (voff)), (PG8_LAS unsigned*)(lds + (bufoff) + ldsw + _i * 8192), 16, 0, 0); } while (0)
#define PG8_LDA(dst, b, h) do { _Pragma("unroll") for (int m = 0; m < 4; ++m) _Pragma("unroll") for (int k = 0; k < 2; ++k) dst[m][k] = *(const PG8_LAS bf16x8*)(lds + PG8_SA(b, h) + aoff + m * 2048 + k * 1024); } while (0)
#define PG8_LDB(dst, b, h) do { _Pragma("unroll") for (int n = 0; n < 2; ++n) _Pragma("unroll") for (int k = 0; k < 2; ++k) dst[n][k] = *(const PG8_LAS bf16x8*)(lds + PG8_SB(b, h) + boff + n * 2048 + k * 1024); } while (0)
#define PG8_MMA(ai, bj, At, Bt) do { __builtin_amdgcn_s_setprio(1); _Pragma("unroll") for (int m = 0; m < 4; ++m) _Pragma("unroll") for (int n = 0; n < 2; ++n) _Pragma("unroll") for (int k = 0; k < 2; ++k) \
        acc[ai][bj][m][n] = __builtin_amdgcn_mfma_f32_16x16x32_bf16(Bt[n][k], At[m][k], acc[ai][bj][m][n], 0, 0, 0); __builtin_amdgcn_s_setprio(0); } while (0)
#define PG8_WAIT_V(n) asm volatile("s_waitcnt vmcnt(" #n ")" ::: "memory")
#define PG8_WAIT_L(n) asm volatile("s_waitcnt lgkmcnt(" #n ")" ::: "memory")
#define PG8_BAR __builtin_amdgcn_s_barrier()
#define PG8_SCHED __builtin_amdgcn_sched_barrier(0)
    Unit cur, nxt; int ui = 0;
    if (!S.next(0, cur)) return;
    f32x4 acc[2][2][4][2];
#pragma unroll
    for (int a = 0; a < 2; ++a)
#pragma unroll
        for (int b = 0; b < 2; ++b)
#pragma unroll
            for (int m = 0; m < 4; ++m)
#pragma unroll
                for (int n = 0; n < 2; ++n) acc[a][b][m][n] = (f32x4){0.f, 0.f, 0.f, 0.f};
    bf16x8 At[4][2], B0[2][2], B1[2][2];
    const char* cA = (const char*)g.A + (size_t)cur.pm * tstepA; const char* cB = (const char*)g.Bt + (size_t)cur.pn * tstepB;
    S.a_ready(cur);
    if constexpr (SP2) {
        PG8_STAGE(PG8_SB(0, 0), cB, voffB); PG8_STAGE(PG8_SB(0, 1), cB + hstepB, voffB); PG8_STAGE(PG8_SA(0, 0), cA, voffA); PG8_STAGE(PG8_SA(0, 1), cA + hstepA, voffA);
        if (wr == 1) PG8_BAR;
        PG8_WAIT_V(2); PG8_BAR;
        PG8_STAGE(PG8_SB(1, 0), cB + kstep, voffB); PG8_STAGE(PG8_SA(1, 0), cA + kstep, voffA); PG8_STAGE(PG8_SB(1, 1), cB + hstepB + kstep, voffB);
        PG8_WAIT_V(6); PG8_BAR;
    } else {
        PG8_STAGE(PG8_SB(0, 0), cB, voffB); PG8_STAGE(PG8_SA(0, 0), cA, voffA); PG8_STAGE(PG8_SB(0, 1), cB + hstepB, voffB); PG8_STAGE(PG8_SA(0, 1), cA + hstepA, voffA);
        if (wr == 1) PG8_BAR;
        PG8_WAIT_V(4); PG8_BAR;
        PG8_STAGE(PG8_SB(1, 0), cB + kstep, voffB); PG8_STAGE(PG8_SA(1, 0), cA + kstep, voffA); PG8_STAGE(PG8_SB(1, 1), cB + hstepB + kstep, voffB);
        PG8_WAIT_V(6); PG8_BAR;
    }
    for (;;) {
        const bool has_next = S.next(ui + 1, nxt);
        const char* nA = has_next ? (const char*)g.A + (size_t)nxt.pm * tstepA : cA; const char* nB = has_next ? (const char*)g.Bt + (size_t)nxt.pn * tstepB : cB;
        for (int t = 0; t < nt; t += 2) {
            const bool last = (t == nt - 2);
            const char* a1 = cA + (size_t)(t + 1) * kstep;
            const char* a2 = last ? nA : cA + (size_t)(t + 2) * kstep; const char* b2 = last ? nB : cB + (size_t)(t + 2) * kstep;
            const char* a3 = a2 + kstep; const char* b3 = b2 + kstep;
            if (last && has_next) S.a_ready(nxt);
            if constexpr (SP2) {
            PG8_LDB(B0, 0, 0); PG8_LDB(B1, 0, 1); PG8_SCHED; PG8_LDA(At, 0, 0); PG8_STAGE(PG8_SA(1, 1), a1 + hstepA, voffA);
            PG8_WAIT_V(8); PG8_WAIT_L(0); PG8_BAR; PG8_MMA(0, 0, At, B0); PG8_MMA(0, 1, At, B1); PG8_BAR; PG8_SCHED;
            PG8_LDA(At, 0, 1); PG8_STAGE(PG8_SB(0, 0), b2, voffB); PG8_STAGE(PG8_SB(0, 1), b2 + hstepB, voffB); PG8_STAGE(PG8_SA(0, 0), a2, voffA);
            PG8_WAIT_V(8); PG8_WAIT_L(0); PG8_BAR; PG8_MMA(1, 0, At, B0); PG8_MMA(1, 1, At, B1); PG8_BAR; PG8_SCHED;
            PG8_LDB(B0, 1, 0); PG8_LDB(B1, 1, 1); PG8_SCHED; PG8_LDA(At, 1, 0); PG8_STAGE(PG8_SA(0, 1), a2 + hstepA, voffA);
            PG8_WAIT_V(8); PG8_WAIT_L(0); PG8_BAR; PG8_MMA(0, 0, At, B0); PG8_MMA(0, 1, At, B1); PG8_BAR; PG8_SCHED;
            PG8_LDA(At, 1, 1); PG8_STAGE(PG8_SB(1, 0), b3, voffB); PG8_STAGE(PG8_SB(1, 1), b3 + hstepB, voffB); PG8_STAGE(PG8_SA(1, 0), a3, voffA);
            PG8_WAIT_V(8); PG8_WAIT_L(0); PG8_BAR; PG8_MMA(1, 0, At, B0); PG8_MMA(1, 1, At, B1); PG8_BAR; PG8_SCHED;
            } else {
            PG8_LDB(B0, 0, 0); PG8_SCHED; PG8_LDA(At, 0, 0); PG8_STAGE(PG8_SA(1, 1), a1 + hstepA, voffA);
            PG8_WAIT_L(8); PG8_BAR; PG8_WAIT_L(0); PG8_MMA(0, 0, At, B0); PG8_BAR; PG8_SCHED;
            PG8_LDB(B1, 0, 1); PG8_STAGE(PG8_SB(0, 0), b2, voffB);
            PG8_BAR; PG8_WAIT_L(0); PG8_MMA(0, 1, At, B1); PG8_BAR;
            PG8_LDA(At, 0, 1); PG8_STAGE(PG8_SA(0, 0), a2, voffA);
            PG8_BAR; PG8_WAIT_L(0); PG8_MMA(1, 0, At, B0); PG8_BAR; PG8_SCHED;
            PG8_STAGE(PG8_SB(0, 1), b2 + hstepB, voffB);
            PG8_WAIT_V(6); PG8_BAR; PG8_MMA(1, 1, At, B1); PG8_BAR;
            PG8_LDB(B0, 1, 0); PG8_SCHED; PG8_LDA(At, 1, 0); PG8_STAGE(PG8_SA(0, 1), a2 + hstepA, voffA);
            PG8_WAIT_L(8); PG8_BAR; PG8_WAIT_L(0); PG8_MMA(0, 0, At, B0); PG8_BAR; PG8_SCHED;
            PG8_LDB(B1, 1, 1); PG8_STAGE(PG8_SB(1, 0), b3, voffB);
            PG8_BAR; PG8_WAIT_L(0); PG8_MMA(0, 1, At, B1); PG8_BAR;
            PG8_LDA(At, 1, 1); PG8_STAGE(PG8_SA(1, 0), a3, voffA);
            PG8_BAR; PG8_WAIT_L(0); PG8_MMA(1, 0, At, B0); PG8_BAR; PG8_SCHED;
            PG8_STAGE(PG8_SB(1, 1), b3 + hstepB, voffB);
            PG8_WAIT_V(6); PG8_BAR; PG8_MMA(1, 1, At, B1); PG8_BAR;
            }
        }
        if constexpr (ALIGN_EPI) { if (wr == 0) PG8_BAR; }
        if constexpr (!Epi::AFTER_DRAIN) { E(acc, cur, wr, wc, fr, fq); S.done(cur); }
        if (!has_next) break;
#pragma unroll
        for (int a = 0; a < 2; ++a)
#pragma unroll
            for (int b = 0; b < 2; ++b)
#pragma unroll
                for (int m = 0; m < 4; ++m)
#pragma unroll
                    for (int n = 0; n < 2; ++n) acc[a][b][m][n] = (f32x4){0.f, 0.f, 0.f, 0.f};
        cur = nxt; cA = nA; cB = nB; ++ui;
        if constexpr (ALIGN_EPI) { if (wr == 1) PG8_BAR; }
    }
    PG8_WAIT_V(0);
    if constexpr (!ALIGN_EPI) { if (wr == 0) PG8_BAR; }
    PG8_BAR;
    if constexpr (Epi::AFTER_DRAIN) { E.fused(acc, cur, wr, wc, fr, fq, lds, wid, lane); S.done(cur); }
#undef PG8_SA
#undef PG8_SB
#undef PG8_STAGE
#undef PG8_LDA
#undef PG8_LDB
#undef PG8_MMA
#undef PG8_WAIT_V
#undef PG8_WAIT_L
#undef PG8_BAR
#undef PG8_SCHED
}

struct EpiInProj {
    static constexpr bool PERM = true, AFTER_DRAIN = false;
    bf16_t* O; const float* rs; float* ssq_q; float* ssq_kv;
    __device__ __forceinline__ void operator()(const f32x4 (&acc)[2][2][4][2], const Unit& u, int wr, int wc, int fr, int fq) const {
        const int row0 = u.pm * BM + wr * 64 + fr, col0 = u.pn * BM + wc * 32 + 8 * fq;
#pragma unroll
        for (int ai = 0; ai < 2; ++ai)
#pragma unroll
            for (int m = 0; m < 4; ++m) {
                const int row = row0 + ai * HALF + m * 16; const float r = rs[row];
                bf16_t* rowp = O + (size_t)row * NP + col0; float ss[2];
#pragma unroll
                for (int bj = 0; bj < 2; ++bj) { const f32x4 v0 = acc[ai][bj][m][0] * r, v1 = acc[ai][bj][m][1] * r;
                    u32x4 w; w.x = pk2(v0[0], v0[1]); w.y = pk2(v0[2], v0[3]); w.z = pk2(v1[0], v1[1]); w.w = pk2(v1[2], v1[3]);
                    *(u32x4*)(rowp + bj * HALF) = w;
                    ss[bj] = (v0[0] * v0[0] + v0[1] * v0[1]) + (v0[2] * v0[2] + v0[3] * v0[3]) + (v1[0] * v1[0] + v1[1] * v1[1]) + (v1[2] * v1[2] + v1[3] * v1[3]); }
                if (u.pn == 3 || u.pn == 4) {
                    float s = u.pn == 3 ? ss[0] + ss[1] : ss[0];
                    s += __shfl_xor(s, 16); s += __shfl_xor(s, 32);
                    if (fq == 0) ((u.pn == 3 ? ssq_q : ssq_kv) + (size_t)row * 4)[wc] = s;
                }
            }
    }
};
struct EpiF32 {
    static constexpr bool PERM = false, AFTER_DRAIN = false;
    float* O; int ldc;
    __device__ __forceinline__ void operator()(const f32x4 (&acc)[2][2][4][2], const Unit& u, int wr, int wc, int fr, int fq) const {
        const int row0 = u.pm * BM + wr * 64 + fr, col0 = u.pn * BM + wc * 32 + 4 * fq;
#pragma unroll
        for (int ai = 0; ai < 2; ++ai)
#pragma unroll
            for (int m = 0; m < 4; ++m) { float* rowp = O + (size_t)(row0 + ai * HALF + m * 16) * ldc + col0;
#pragma unroll
                for (int bj = 0; bj < 2; ++bj)
#pragma unroll
                    for (int n = 0; n < 2; ++n) *(f32x4*)(rowp + bj * HALF + n * 16) = acc[ai][bj][m][n]; }
    }
};
}

DI void pro_all(const Params& p, int gtid, int gsize) {
    for (int i = gtid; i < 12 * BT_STRIDE; i += gsize) { const int h = i / BT_STRIDE, d = i % BT_STRIDE; ((float*)(p.ws + WS_BTAB))[i] = p.rel_bias[h * 32 + t5_bucket(d)]; }
    for (int i = gtid; i < DEPTH * NP * (D / 8); i += gsize) {
        const int n = i % NP, k8 = (i / NP) % (D / 8), l = i / (NP * (D / 8));
        const int sc = src_col(n);
        float v[8];
#pragma unroll
        for (int j = 0; j < 8; ++j) { const int k = k8 * 8 + j; v[j] = sc >= 0 ? p.w_in[((size_t)l * D + k) * DIN + sc] * p.norm_pre[l * D + k] : 0.f; }
        uint4 w; w.x = pk2(v[0], v[1]); w.y = pk2(v[2], v[3]); w.z = pk2(v[4], v[5]); w.w = pk2(v[6], v[7]);
        *(uint4*)(((bf16_t*)(p.ws + WS_WTIN)) + ((size_t)l * NP + n) * D + k8 * 8) = w;
    }
    for (int i = gtid; i < DEPTH * D * (D / 8); i += gsize) {
        const int n = i % D, k8 = (i / D) % (D / 8), l = i / (D * (D / 8));
        float v[8];
#pragma unroll
        for (int j = 0; j < 8; ++j) v[j] = p.w_out[((size_t)l * D + k8 * 8 + j) * D + n];
        uint4 w; w.x = pk2(v[0], v[1]); w.y = pk2(v[2], v[3]); w.z = pk2(v[4], v[5]); w.w = pk2(v[6], v[7]);
        *(uint4*)(((bf16_t*)(p.ws + WS_WTOUT)) + ((size_t)l * D + n) * D + k8 * 8) = w;
    }
}
DI void pro_xrow(const Params& p, int row, int lane) {
    const float4* xp = (const float4*)(p.x_in + (size_t)row * D);
    float s = 0.f;
#pragma unroll
    for (int i = 0; i < 4; ++i) { const float4 v = xp[lane + 64 * i]; s += v.x * v.x + v.y * v.y + v.z * v.z + v.w * v.w;
        uint2 w; w.x = pk2(v.x, v.y); w.y = pk2(v.z, v.w); ((uint2*)(((bf16_t*)(p.ws + WS_XB)) + (size_t)row * D))[lane + 64 * i] = w; }
    for (int o = 32; o > 0; o >>= 1) s += __shfl_xor(s, o);
    if (lane == 0) ((float*)(p.ws + WS_RS))[row] = rsqrtf(s * (1.0f / D) + 1e-6f);
}
DI void post_row(const Params& p, int layer, int row, int lane) {
    const float* x = (layer == 0 ? p.x_in : p.xout) + (size_t)row * D;
    const float* y = ((float*)(p.ws + WS_P)) + (size_t)row * D;
    const float* g = p.norm_post + layer * D;
    float4 yv[4]; float s = 0.f;
#pragma unroll
    for (int i = 0; i < 4; ++i) { yv[i] = ((const float4*)y)[lane + 64 * i]; s += yv[i].x * yv[i].x + yv[i].y * yv[i].y + yv[i].z * yv[i].z + yv[i].w * yv[i].w; }
    for (int o = 32; o > 0; o >>= 1) s += __shfl_xor(s, o);
    const float r = rsqrtf(s * (1.f / D) + 1e-6f);
    float s2 = 0.f;
#pragma unroll
    for (int i = 0; i < 4; ++i) {
        const float4 xv = ((const float4*)x)[lane + 64 * i], gv = ((const float4*)g)[lane + 64 * i];
        float4 o; o.x = xv.x + yv[i].x * r * gv.x; o.y = xv.y + yv[i].y * r * gv.y; o.z = xv.z + yv[i].z * r * gv.z; o.w = xv.w + yv[i].w * r * gv.w;
        ((float4*)(p.xout + (size_t)row * D))[lane + 64 * i] = o;
        uint2 w; w.x = pk2(o.x, o.y); w.y = pk2(o.z, o.w); ((uint2*)(((bf16_t*)(p.ws + WS_XB)) + (size_t)row * D))[lane + 64 * i] = w;
        s2 += o.x * o.x + o.y * o.y + o.z * o.z + o.w * o.w;
    }
    for (int o = 32; o > 0; o >>= 1) s2 += __shfl_xor(s2, o);
    if (lane == 0) ((float*)(p.ws + WS_RS))[row] = rsqrtf(s2 * (1.f / D) + 1e-6f);
}

DI void b_mla_up(const Params& p, int T512, int layer, int vb, char* smem) {
    float (*cq)[256] = (float (*)[256])smem;
    float (*ckv)[128] = (float (*)[128])(smem + 8192);
    float (*qb)[384] = (float (*)[384])(smem + 8192 + 4096);
    float (*red)[2] = (float (*)[2])(smem + 8192 + 4096 + 12288);
    const int tid = T512 & 255, tok0 = vb * 8;
    {
        const int tk = tid >> 5, l32 = tid & 31;
        float s1 = 0.f, s2 = 0.f;
        for (int k = l32; k < 256; k += 32) { float v = bf2f(((bf16_t*)(p.ws + WS_P))[(size_t)(tok0 + tk) * NP + C_BCQ + k]); cq[tk][k] = v; s1 += v * v; }
        for (int k = l32; k < 128; k += 32) { float v = bf2f(((bf16_t*)(p.ws + WS_P))[(size_t)(tok0 + tk) * NP + C_BCKV + k]); ckv[tk][k] = v; s2 += v * v; }
        for (int o = 16; o > 0; o >>= 1) { s1 += __shfl_xor(s1, o); s2 += __shfl_xor(s2, o); }
        if (l32 == 0) { const float4 a = ((const float4*)(p.ws + WS_SSQQ))[tok0 + tk], bq = ((const float4*)(p.ws + WS_SSQKV))[tok0 + tk];
            red[tk][0] = rsqrtf(((a.x + a.y) + (a.z + a.w)) * (1.f / 256.f) + 1e-6f); red[tk][1] = rsqrtf(((bq.x + bq.y) + (bq.z + bq.w)) * (1.f / 128.f) + 1e-6f); }
    }
    __syncthreads();
    {
        const int tk = tid >> 5, l32 = tid & 31;
        for (int k = l32; k < 256; k += 32) cq[tk][k] *= red[tk][0] * p.q_norm[layer * 256 + k];
        for (int k = l32; k < 128; k += 32) ckv[tk][k] *= red[tk][1] * p.kv_norm[layer * 128 + k];
    }
    __syncthreads();
    const float* wq = p.w_uq + (size_t)layer * 256 * 384;
    for (int j = tid; j < 384; j += 256) {
        float acc[8] = {0, 0, 0, 0, 0, 0, 0, 0};
        for (int k = 0; k < 256; ++k) { const float w = wq[k * 384 + j];
#pragma unroll
            for (int tk = 0; tk < 8; ++tk) acc[tk] += cq[tk][k] * w; }
#pragma unroll
        for (int tk = 0; tk < 8; ++tk) qb[tk][j] = acc[tk];
    }
    const float* wkv = p.w_ukv + (size_t)layer * 128 * 512;
    for (int j = tid; j < 512; j += 256) {
        float acc[8] = {0, 0, 0, 0, 0, 0, 0, 0};
        for (int k = 0; k < 128; ++k) { const float w = wkv[k * 512 + j];
#pragma unroll
            for (int tk = 0; tk < 8; ++tk) acc[tk] += ckv[tk][k] * w; }
        const int h = j >> 7, e = j & 127;
#pragma unroll
        for (int tk = 0; tk < 8; ++tk) {
            if (e < 64) ((bf16_t*)(p.ws + WS_KM))[(size_t)(tok0 + tk) * 384 + h * 96 + e] = f2bf(acc[tk]);
            else ((bf16_t*)(p.ws + WS_VM))[(size_t)(tok0 + tk) * 256 + h * 64 + (e - 64)] = f2bf(acc[tk]);
        }
    }
    __syncthreads();
    for (int idx = tid; idx < 8 * 4 * 64; idx += 256) {
        const int tk = idx >> 8, h = (idx >> 6) & 3, e = idx & 63;
        ((bf16_t*)(p.ws + WS_QM))[(size_t)(tok0 + tk) * 384 + h * 96 + e] = f2bf(qb[tk][h * 96 + e]);
    }
    for (int idx = tid; idx < 8 * 5 * 16; idx += 256) {
        const int tk = idx / 80, r = idx % 80, h = r >> 4, i = r & 15;
        const int tok = tok0 + tk, pos = tok % T;
        const float inv = powf(10000.0f, -(float)i / 16.0f);
        const float ang = (float)pos * inv;
        const float cs = cosf(ang), sn = sinf(ang);
        if (h < 4) {
            const float x1 = qb[tk][h * 96 + 64 + i], x2 = qb[tk][h * 96 + 80 + i];
            ((bf16_t*)(p.ws + WS_QM))[(size_t)tok * 384 + h * 96 + 64 + i] = f2bf(x1 * cs - x2 * sn);
            ((bf16_t*)(p.ws + WS_QM))[(size_t)tok * 384 + h * 96 + 80 + i] = f2bf(x2 * cs + x1 * sn);
        } else {
            const float x1 = bf2f(((bf16_t*)(p.ws + WS_P))[(size_t)tok * NP + C_BKR + i]), x2 = bf2f(((bf16_t*)(p.ws + WS_P))[(size_t)tok * NP + C_BKR + 16 + i]);
            const bf16_t o1 = f2bf(x1 * cs - x2 * sn), o2 = f2bf(x2 * cs + x1 * sn);
            for (int hh = 0; hh < 4; ++hh) { ((bf16_t*)(p.ws + WS_KM))[(size_t)tok * 384 + hh * 96 + 64 + i] = o1; ((bf16_t*)(p.ws + WS_KM))[(size_t)tok * 384 + hh * 96 + 80 + i] = o2; }
        }
    }
}

DI void b_compress(const Params& p, int T512, int layer, int bx, int which, int b, char* smem) {
    float (*tok)[64] = (float (*)[64])smem;
    float (*pe)[64] = (float (*)[64])(smem + 144 * 64 * 4);
    float (*hid)[128] = (float (*)[128])(smem + 144 * 64 * 4 + 32 * 64 * 4);
    const int tid = T512 & 255, c0 = bx * 8;
    const int col = which == 0 ? C_KCMP : C_VCMP;
    for (int idx = tid; idx < 144 * 64; idx += 256) {
        const int r = idx >> 6, d = idx & 63, t = c0 * 16 + r;
        tok[r][d] = t < T ? bf2f(((bf16_t*)(p.ws + WS_P))[(size_t)(b * T + t) * NP + col + d]) : 0.f;
    }
    const float* pep = p.cmp_pos + ((size_t)layer * 2 + which) * 32 * 64;
    for (int idx = tid; idx < 32 * 64; idx += 256) pe[idx >> 6][idx & 63] = pep[idx];
    __syncthreads();
    const int j = tid & 127, half = tid >> 7;
    const float* w1 = p.cmp_w1 + ((size_t)layer * 2 + which) * 2048 * 128;
    float acc[4] = {0, 0, 0, 0};
    for (int i = 0; i < 32; ++i)
        for (int d = 0; d < 64; ++d) {
            const float w = w1[(size_t)(i * 64 + d) * 128 + j], pp = pe[i][d];
#pragma unroll
            for (int cc = 0; cc < 4; ++cc) acc[cc] += (tok[(half * 4 + cc) * 16 + i][d] + pp) * w;
        }
#pragma unroll
    for (int cc = 0; cc < 4; ++cc) { const float a = acc[cc]; hid[half * 4 + cc][j] = a / (1.f + expf(-a)); }
    __syncthreads();
    const float* w2 = p.cmp_w2 + ((size_t)layer * 2 + which) * 128 * 64;
    bf16_t* outp = which == 0 ? ((bf16_t*)(p.ws + WS_KC)) : ((bf16_t*)(p.ws + WS_VC));
    for (int idx = tid; idx < 8 * 64; idx += 256) {
        const int cc = idx >> 6, d = idx & 63, c = c0 + cc;
        float s = 0.f;
        for (int jj = 0; jj < 128; ++jj) s += hid[cc][jj] * w2[jj * 64 + d];
        outp[((size_t)b * 256 + c) * 64 + d] = c < 255 ? f2bf(s) : (bf16_t)0;
    }
}

namespace att {
#define ALAS __attribute__((address_space(3)))
typedef short bf16x8 __attribute__((ext_vector_type(8)));
typedef short s16x4 __attribute__((ext_vector_type(4)));
typedef short v4i16_t __attribute__((ext_vector_type(4)));
typedef float f32x16 __attribute__((ext_vector_type(16)));
typedef unsigned u32x4_t __attribute__((ext_vector_type(4)));
typedef float f32x2_t __attribute__((ext_vector_type(2)));
typedef __bf16 bf16x2_t __attribute__((ext_vector_type(2)));
constexpr float LOG2E = 1.4426950408889634f;
constexpr float NEGB = -1e30f;
constexpr int DMAXT = 640, TABN = 712;

DI unsigned cvtpk(float lo, float hi) { f32x2_t v = {lo, hi}; bf16x2_t b = __builtin_convertvector(v, bf16x2_t); return __builtin_bit_cast(unsigned, b); }
DI s16x4 vtr(const ALAS char* p) { return __builtin_bit_cast(s16x4, __builtin_amdgcn_ds_read_tr16_b64_v4i16((ALAS v4i16_t*)p)); }
DI bf16x8 pack8(const f32x16& x, int s8) {
    u32x4_t w; w.x = cvtpk(x[s8 + 0], x[s8 + 1]); w.y = cvtpk(x[s8 + 2], x[s8 + 3]); w.z = cvtpk(x[s8 + 4], x[s8 + 5]); w.w = cvtpk(x[s8 + 6], x[s8 + 7]);
    return __builtin_bit_cast(bf16x8, w);
}
template <int DK> DI void k_offsets(int lane, unsigned (&ko)[DK / 16]) {
    const int r32 = lane & 31, hi = lane >> 5;
    const int x = (DK == 64) ? ((r32 >> 1) & 7) : ((r32 >> 2) & 3);
#pragma unroll
    for (int ks = 0; ks < DK / 16; ++ks) ko[ks] = (unsigned)(r32 * (DK * 2) + 16 * ((2 * ks + hi) ^ x));
}
DI void v_offsets(int lane, unsigned (&vo)[2]) {
    const int hi = lane >> 5, qp = (lane & 15) >> 2, sft = qp >> 1, d0 = 16 * ((lane >> 4) & 1) + 4 * (lane & 3);
#pragma unroll
    for (int db = 0; db < 2; ++db) vo[db] = (unsigned)((4 * hi + qp) * 128 + 64 * (db ^ sft) + 2 * d0);
}
DI unsigned k64_dst(int row, int ch) { return (unsigned)(row * 128 + 16 * (ch ^ ((row >> 1) & 7))); }
DI unsigned k96_dst(int row, int ch) { return (unsigned)(row * 192 + 16 * (ch ^ ((row >> 2) & 3))); }
DI unsigned v64_dst(int row, int ch) { return (unsigned)(row * 128 + 16 * (ch ^ (((row >> 1) & 1) << 2))); }

template <int DK, int MODE>
DI void tile_step(const ALAS char* kt, const ALAS char* vt, const unsigned (&ko)[DK / 16], const unsigned (&vo)[2], const bf16x8 (&qf)[DK / 16],
                  float c, float cb, const ALAS float* tb, float& m, float& l, f32x16 (&o)[2]) {
    f32x16 s0, s1;
#pragma unroll
    for (int r = 0; r < 16; ++r) { s0[r] = 0.f; s1[r] = 0.f; }
#pragma unroll
    for (int ks = 0; ks < DK / 16; ++ks) {
        const bf16x8 k0 = *(const ALAS bf16x8*)(kt + ko[ks]);
        const bf16x8 k1 = *(const ALAS bf16x8*)(kt + ko[ks] + 32 * DK * 2);
        s0 = __builtin_amdgcn_mfma_f32_32x32x16_bf16(k0, qf[ks], s0, 0, 0, 0);
        s1 = __builtin_amdgcn_mfma_f32_32x32x16_bf16(k1, qf[ks], s1, 0, 0, 0);
    }
    __builtin_amdgcn_sched_barrier(0);
    if (MODE == 0) {
#pragma unroll
        for (int r = 0; r < 16; ++r) { s0[r] = __builtin_fmaf(s0[r], c, cb); s1[r] = __builtin_fmaf(s1[r], c, cb); }
    } else {
#pragma unroll
        for (int r = 0; r < 16; ++r) { const int e = (r & 3) + 8 * (r >> 2); s0[r] = __builtin_fmaf(s0[r], c, tb[e]); s1[r] = __builtin_fmaf(s1[r], c, tb[32 + e]); }
    }
    float mt = __builtin_fmaxf(s0[0], s1[0]);
#pragma unroll
    for (int r = 1; r < 16; ++r) mt = __builtin_fmaxf(mt, __builtin_fmaxf(s0[r], s1[r]));
    mt = __builtin_fmaxf(mt, __shfl_xor(mt, 32));
    if (__any(mt > m)) {
        const float mn = __builtin_fmaxf(m, mt), a = __builtin_amdgcn_exp2f(m - mn);
        m = mn; l *= a;
#pragma unroll
        for (int r = 0; r < 16; ++r) { o[0][r] *= a; o[1][r] *= a; }
    }
    float rs = 0.f;
#pragma unroll
    for (int r = 0; r < 16; ++r) { s0[r] = __builtin_amdgcn_exp2f(s0[r] - m); s1[r] = __builtin_amdgcn_exp2f(s1[r] - m); rs += s0[r] + s1[r]; }
    l += rs;
    bf16x8 pf[4];
    pf[0] = pack8(s0, 0); pf[1] = pack8(s0, 8); pf[2] = pack8(s1, 0); pf[3] = pack8(s1, 8);
    __builtin_amdgcn_sched_barrier(0);
#pragma unroll
    for (int db = 0; db < 2; ++db)
#pragma unroll
        for (int kk = 0; kk < 4; ++kk) {
            const s16x4 lo = vtr(vt + vo[db] + kk * 2048), hh = vtr(vt + vo[db] + kk * 2048 + 1024);
            const bf16x8 vf = (bf16x8){lo[0], lo[1], lo[2], lo[3], hh[0], hh[1], hh[2], hh[3]};
            o[db] = __builtin_amdgcn_mfma_f32_32x32x16_bf16(vf, pf[kk], o[db], 0, 0, 0);
        }
    __builtin_amdgcn_sched_barrier(0);
}

constexpr int L_K0 = 0, L_K1 = 12288, L_V0 = 24576, L_V1 = 32768, L_TAB = 40960;

DI void build_table(ALAS float* A, const float* bt, int W, int tid, int nthreads) {
    for (int i = tid; i < TABN; i += nthreads) { const int d = DMAXT - i; float v = NEGB; if (d >= 0 && d < W) v = bt ? LOG2E * bt[d < 512 ? d : 512] : 0.f; A[i] = v; }
}

DI void mla_unit(const Params& p, int tid, ALAS char* lds, int b, int h, int qt) {
    const int lane = tid & 63, w = __builtin_amdgcn_readfirstlane(tid >> 6), r32 = lane & 31, hi = lane >> 5;
    const int tq = 256 * qt + 32 * w + r32;
    const bf16_t* Qm = (const bf16_t*)(p.ws + WS_QM); const bf16_t* Km = (const bf16_t*)(p.ws + WS_KM); const bf16_t* Vm = (const bf16_t*)(p.ws + WS_VM);
    bf16x8 qf[6];
    { const bf16_t* qrow = Qm + ((size_t)b * T + tq) * 384 + h * 96;
#pragma unroll
      for (int ks = 0; ks < 6; ++ks) qf[ks] = *(const bf16x8*)(qrow + 16 * ks + 8 * hi); }
    unsigned ko[6], vo[2]; k_offsets<96>(lane, ko); v_offsets(lane, vo);
    f32x16 o[2];
#pragma unroll
    for (int r = 0; r < 16; ++r) { o[0][r] = 0.f; o[1][r] = 0.f; }
    float m = NEGB, l = 0.f;
    const float c = 0.10206207261596577f * LOG2E;
    const int ntiles = 4 * qt + 4, mylast = 4 * qt + (w >> 1);
    const ALAS float* tabA = (const ALAS float*)(lds + L_TAB);
    const int kr0 = tid / 12, kc0 = tid % 12, kr1 = (tid + 512) / 12, kc1 = (tid + 512) % 12, vr = tid >> 3, vc = tid & 7;
    const bf16_t* ksrc0 = Km + ((size_t)b * T + kr0) * 384 + h * 96 + kc0 * 8;
    const bf16_t* ksrc1 = Km + ((size_t)b * T + kr1) * 384 + h * 96 + kc1 * 8;
    const bf16_t* vsrc = Vm + ((size_t)b * T + vr) * 256 + h * 64 + vc * 8;
    const unsigned kd0 = k96_dst(kr0, kc0), kd1 = k96_dst(kr1, kc1), vd = v64_dst(vr, vc);
    u32x4_t ka, kb = (u32x4_t){0u, 0u, 0u, 0u}, va;
    ka = *(const u32x4_t*)ksrc0; if (tid < 256) kb = *(const u32x4_t*)ksrc1; va = *(const u32x4_t*)vsrc;
    *(ALAS u32x4_t*)(lds + L_K0 + kd0) = ka; if (tid < 256) *(ALAS u32x4_t*)(lds + L_K0 + kd1) = kb; *(ALAS u32x4_t*)(lds + L_V0 + vd) = va;
    __syncthreads();
    for (int jt = 0; jt < ntiles; ++jt) {
        const int cur = jt & 1;
        if (jt + 1 < ntiles) { const size_t adv = (size_t)(jt + 1) * 64;
            ka = *(const u32x4_t*)(ksrc0 + adv * 384); if (tid < 256) kb = *(const u32x4_t*)(ksrc1 + adv * 384); va = *(const u32x4_t*)(vsrc + adv * 256); }
        if (jt <= mylast) {
            const ALAS char* kt = lds + (cur ? L_K1 : L_K0); const ALAS char* vt = lds + (cur ? L_V1 : L_V0);
            if (jt == mylast) { const int D0 = tq - 64 * jt - 4 * hi; tile_step<96, 1>(kt, vt, ko, vo, qf, c, 0.f, tabA + (DMAXT - D0), m, l, o); }
            else tile_step<96, 0>(kt, vt, ko, vo, qf, c, 0.f, tabA, m, l, o);
        }
        if (jt + 1 < ntiles) { ALAS char* kn = lds + (cur ? L_K0 : L_K1); ALAS char* vn = lds + (cur ? L_V0 : L_V1);
            *(ALAS u32x4_t*)(kn + kd0) = ka; if (tid < 256) *(ALAS u32x4_t*)(kn + kd1) = kb; *(ALAS u32x4_t*)(vn + vd) = va; }
        __syncthreads();
    }
    l += __shfl_xor(l, 32);
    const float invl = 1.f / l;
    const size_t tok = (size_t)b * T + tq;
    const bf16_t* zp = (const bf16_t*)(p.ws + WS_P) + tok * NP + C_Z + 256 + 64 * h;
    bf16_t* mp = (bf16_t*)(p.ws + WS_MIX) + tok * 1024 + 256 + 64 * h;
#pragma unroll
    for (int db = 0; db < 2; ++db)
#pragma unroll
        for (int g = 0; g < 4; ++g) {
            const int d = 32 * db + 8 * g + 4 * hi;
            const uint2 zw = *(const uint2*)(zp + d);
            const float z0 = bflo(zw.x), z1 = bfhi(zw.x), z2 = bflo(zw.y), z3 = bfhi(zw.y);
            const float v0 = o[db][4 * g + 0] * invl * z0 / (1.f + __expf(-z0)), v1 = o[db][4 * g + 1] * invl * z1 / (1.f + __expf(-z1));
            const float v2 = o[db][4 * g + 2] * invl * z2 / (1.f + __expf(-z2)), v3 = o[db][4 * g + 3] * invl * z3 / (1.f + __expf(-z3));
            uint2 ow; ow.x = cvtpk(v0, v1); ow.y = cvtpk(v2, v3);
            *(uint2*)(mp + d) = ow;
        }
}
DI void acc_scaled(f32x16 (&acc)[2], const f32x16 (&o)[2], float f) {
#pragma unroll
    for (int r = 0; r < 16; ++r) { acc[0][r] += f * o[0][r]; acc[1][r] += f * o[1][r]; }
}
DI void store_mixed(const Params& p, const f32x16 (&acc)[2], size_t tok, int mcol, int hi) {
    const bf16_t* zp = (const bf16_t*)(p.ws + WS_P) + tok * NP + C_Z + mcol;
    bf16_t* mp = (bf16_t*)(p.ws + WS_MIX) + tok * 1024 + mcol;
#pragma unroll
    for (int db = 0; db < 2; ++db)
#pragma unroll
        for (int g = 0; g < 4; ++g) {
            const int d = 32 * db + 8 * g + 4 * hi;
            const uint2 zw = *(const uint2*)(zp + d);
            const float z0 = bflo(zw.x), z1 = bfhi(zw.x), z2 = bflo(zw.y), z3 = bfhi(zw.y);
            const float v0 = acc[db][4 * g + 0] * z0 / (1.f + __expf(-z0)), v1 = acc[db][4 * g + 1] * z1 / (1.f + __expf(-z1));
            const float v2 = acc[db][4 * g + 2] * z2 / (1.f + __expf(-z2)), v3 = acc[db][4 * g + 3] * z3 / (1.f + __expf(-z3));
            uint2 ow; ow.x = cvtpk(v0, v1); ow.y = cvtpk(v2, v3);
            *(uint2*)(mp + d) = ow;
        }
}
DI void zero2(f32x16 (&o)[2]) {
#pragma unroll
    for (int r = 0; r < 16; ++r) { o[0][r] = 0.f; o[1][r] = 0.f; }
}
struct Stage64 {
    const bf16_t* ks; const bf16_t* vs; unsigned kd, vd; u32x4_t ka, va;
    DI void init(const bf16_t* kbase, const bf16_t* vbase, size_t pitch, int tid) { const int row = tid >> 3, ch = tid & 7; ks = kbase + row * pitch + ch * 8; vs = vbase + row * pitch + ch * 8; kd = k64_dst(row, ch); vd = v64_dst(row, ch); }
    DI void load(size_t rowoff_elems) { ka = *(const u32x4_t*)(ks + rowoff_elems); va = *(const u32x4_t*)(vs + rowoff_elems); }
    DI void store(ALAS char* kb, ALAS char* vb) const { *(ALAS u32x4_t*)(kb + kd) = ka; *(ALAS u32x4_t*)(vb + vd) = va; }
};

DI void swa_unit(const Params& p, int tid, ALAS char* lds, int layer, int b, int qt) {
    const int lane = tid & 63, w = __builtin_amdgcn_readfirstlane(tid >> 6), r32 = lane & 31, hi = lane >> 5;
    const int tq = 32 * qt + r32; const size_t tok = (size_t)b * T + tq;
    const bf16_t* P = (const bf16_t*)(p.ws + WS_P);
    bf16x8 qf[4];
#pragma unroll
    for (int ks = 0; ks < 4; ++ks) qf[ks] = *(const bf16x8*)(P + tok * NP + C_CQ + 64 * w + 16 * ks + 8 * hi);
    unsigned ko[4], vo[2]; k_offsets<64>(lane, ko); v_offsets(lane, vo);
    f32x16 o[2]; zero2(o);
    float m = NEGB, l = 0.f;
    const float c = 0.125f * LOG2E;
    const int jd = qt >> 1, ntl = jd + 1 < 3 ? jd + 1 : 3;
    const ALAS float* tab = (const ALAS float*)(lds + L_TAB) + w * TABN;
    Stage64 st; st.init(P + (size_t)b * T * NP + C_CK, P + (size_t)b * T * NP + C_CV, NP, tid);
    st.load((size_t)(64 * jd) * NP); st.store(lds + L_K0, lds + L_V0);
    __syncthreads();
    for (int i = 0; i < ntl; ++i) {
        const int cur = i & 1, jt = jd - i;
        if (i + 1 < ntl) st.load((size_t)(64 * (jt - 1)) * NP);
        { const int D0 = tq - 64 * jt - 4 * hi;
          tile_step<64, 1>(lds + (cur ? L_K1 : L_K0), lds + (cur ? L_V1 : L_V0), ko, vo, qf, c, 0.f, tab + (DMAXT - D0), m, l, o); }
        if (i + 1 < ntl) st.store(lds + (cur ? L_K0 : L_K1), lds + (cur ? L_V0 : L_V1));
        __syncthreads();
    }
    l += __shfl_xor(l, 32);
    l += __builtin_amdgcn_exp2f(p.sinks[layer * 8 + w] * LOG2E - m);
    f32x16 acc[2]; zero2(acc); acc_scaled(acc, o, 1.f / l);
    store_mixed(p, acc, tok, 512 + 64 * w, hi);
}

template <bool FIRST> DI void oa_accum(float* oap, const f32x16 (&o)[2], float f, int hi) {
#pragma unroll
    for (int db = 0; db < 2; ++db)
#pragma unroll
        for (int g = 0; g < 4; ++g) {
            float4* q = (float4*)(oap + 32 * db + 8 * g + 4 * hi);
            float4 v = FIRST ? make_float4(0.f, 0.f, 0.f, 0.f) : *q;
            v.x += f * o[db][4 * g + 0]; v.y += f * o[db][4 * g + 1]; v.z += f * o[db][4 * g + 2]; v.w += f * o[db][4 * g + 3];
            *q = v;
        }
}
constexpr int L_TSEL = L_TAB, L_TWIN = L_TAB + 4 * TABN * 4, L_TCMP = L_TWIN + 4 * TABN * 4, CMPN = 520, L_IMP = 73728, L_SELM = L_IMP + 65536, L_UNION = L_SELM + 512;
DI void nsa_tables(const Params& p, int tid, ALAS char* lds) {
    const float* bt = (const float*)(p.ws + WS_BTAB);
    for (int h = 0; h < 4; ++h) {
        build_table((ALAS float*)(lds + L_TSEL) + h * TABN, bt + h * BT_STRIDE, 1 << 30, tid, 512);
        build_table((ALAS float*)(lds + L_TWIN) + h * TABN, bt + h * BT_STRIDE, 512, tid, 512);
        for (int i = tid; i < CMPN; i += 512) ((ALAS float*)(lds + L_TCMP))[h * CMPN + i] = i == 0 ? NEGB : LOG2E * bt[h * BT_STRIDE + (i - 1 < 512 ? i - 1 : 512)];
    }
}
DI void cmp_scores(const ALAS char* kt, const unsigned (&ko)[4], const bf16x8 (&qf)[4], float c, bool far, float cb31, const ALAS float* G, int D0c, f32x16& s0, f32x16& s1) {
#pragma unroll
    for (int r = 0; r < 16; ++r) { s0[r] = 0.f; s1[r] = 0.f; }
#pragma unroll
    for (int ks = 0; ks < 4; ++ks) {
        const bf16x8 k0 = *(const ALAS bf16x8*)(kt + ko[ks]);
        const bf16x8 k1 = *(const ALAS bf16x8*)(kt + ko[ks] + 32 * 128);
        s0 = __builtin_amdgcn_mfma_f32_32x32x16_bf16(k0, qf[ks], s0, 0, 0, 0);
        s1 = __builtin_amdgcn_mfma_f32_32x32x16_bf16(k1, qf[ks], s1, 0, 0, 0);
    }
    __builtin_amdgcn_sched_barrier(0);
    if (far) {
#pragma unroll
        for (int r = 0; r < 16; ++r) { s0[r] = __builtin_fmaf(s0[r], c, cb31); s1[r] = __builtin_fmaf(s1[r], c, cb31); }
    } else {
#pragma unroll
        for (int r = 0; r < 16; ++r) {
            const int e = (r & 3) + 8 * (r >> 2);
            int d0 = D0c - 16 * e, d1 = D0c - 16 * (e + 32);
            d0 = d0 < -1 ? -1 : (d0 > 512 ? 512 : d0); d1 = d1 < -1 ? -1 : (d1 > 512 ? 512 : d1);
            s0[r] = __builtin_fmaf(s0[r], c, G[d0 + 1]); s1[r] = __builtin_fmaf(s1[r], c, G[d1 + 1]);
        }
    }
}
DI void nsa_unit(const Params& p, int tid, ALAS char* lds, int b, int qt) {
    const int lane = tid & 63, w = __builtin_amdgcn_readfirstlane(tid >> 6), r32 = lane & 31, hi = lane >> 5;
    const int h = w & 3, th = w >> 2;
    const int tq = 64 * qt + 32 * th + r32; const size_t tok = (size_t)b * T + tq;
    const bf16_t* P = (const bf16_t*)(p.ws + WS_P);
    bf16x8 qf[4];
#pragma unroll
    for (int ks = 0; ks < 4; ++ks) qf[ks] = *(const bf16x8*)(P + tok * NP + C_AQ + 64 * h + 16 * ks + 8 * hi);
    unsigned ko[4], vo[2]; k_offsets<64>(lane, ko); v_offsets(lane, vo);
    const float c = 0.125f * LOG2E;
    const float* bt = (const float*)(p.ws + WS_BTAB) + h * BT_STRIDE;
    const float b31 = LOG2E * bt[512];
    float g0, g1, g2;
    { const bf16_t* gp = P + tok * NP + C_AG + 3 * h; g0 = 1.f / (1.f + __expf(-bf2f(gp[0]))); g1 = 1.f / (1.f + __expf(-bf2f(gp[1]))); g2 = 1.f / (1.f + __expf(-bf2f(gp[2]))); }
    float* oap = (float*)(p.ws + WS_OA) + tok * 256 + 64 * h;
    Stage64 st;
    const int nvmax = 4 * qt + 3 < 255 ? 4 * qt + 3 : 255, nct = (nvmax + 63) >> 6;
    const ALAS float* G = (const ALAS float*)(lds + L_TCMP) + h * CMPN;
    ALAS float* impw = (ALAS float*)(lds + L_IMP) + (h * 64 + 32 * th + r32) * 64;
    const int tqmin = 64 * qt + 32 * th;
    { float zf = 0.f; asm volatile("" : "+v"(zf));
#pragma unroll
      for (int i = 0; i < 32; ++i) impw[32 * hi + i] = zf; }
    st.init((const bf16_t*)(p.ws + WS_KC) + (size_t)b * 256 * 64, (const bf16_t*)(p.ws + WS_VC) + (size_t)b * 256 * 64, 64, tid);
    float m = NEGB, l = 0.f;
    for (int pass = 0; pass < 2; ++pass) {
        f32x16 o[2]; zero2(o);
        const float invl = (pass == 1 && tq >= 31) ? 1.f / l : 0.f;
        float carry = 0.f;
        __syncthreads();
        st.load(0); st.store(lds + L_K0, lds + L_V0);
        __syncthreads();
        for (int ct = 0; ct < nct; ++ct) {
            const int cur = ct & 1;
            if (ct + 1 < nct) st.load((size_t)(64 * (ct + 1)) * 64);
            const ALAS char* kt = lds + (cur ? L_K1 : L_K0); const ALAS char* vt = lds + (cur ? L_V1 : L_V0);
            const bool far = tqmin - (16 * (64 * ct + 63) + 31) >= 413;
            const int D0c = tq - 31 - 16 * (64 * ct) - 64 * hi;
            f32x16 s0, s1;
            cmp_scores(kt, ko, qf, c, far, b31, G, D0c, s0, s1);
            __builtin_amdgcn_sched_barrier(0);
            if (pass == 0) {
                float mt = __builtin_fmaxf(s0[0], s1[0]);
#pragma unroll
                for (int r = 1; r < 16; ++r) mt = __builtin_fmaxf(mt, __builtin_fmaxf(s0[r], s1[r]));
                mt = __builtin_fmaxf(mt, __shfl_xor(mt, 32));
                const float mn = __builtin_fmaxf(m, mt); l *= __builtin_amdgcn_exp2f(m - mn); m = mn;
                float rs = 0.f;
#pragma unroll
                for (int r = 0; r < 16; ++r) rs += __builtin_amdgcn_exp2f(s0[r] - m) + __builtin_amdgcn_exp2f(s1[r] - m);
                l += rs;
            } else {
#pragma unroll
                for (int r = 0; r < 16; ++r) { s0[r] = __builtin_amdgcn_exp2f(s0[r] - m) * invl; s1[r] = __builtin_amdgcn_exp2f(s1[r] - m) * invl; }
                bf16x8 pf[4];
                pf[0] = pack8(s0, 0); pf[1] = pack8(s0, 8); pf[2] = pack8(s1, 0); pf[3] = pack8(s1, 8);
                __builtin_amdgcn_sched_barrier(0);
                f32x16 im;
#pragma unroll
                for (int r = 0; r < 16; ++r) im[r] = 0.f;
#pragma unroll
                for (int kk = 0; kk < 4; ++kk) {
                    bf16x8 of;
#pragma unroll
                    for (int j = 0; j < 8; ++j) { const int cl = 16 * kk + 8 * (j >> 2) + 4 * hi + (j & 3); const int sb = cl >> 2; const bool last = (cl & 3) == 3;
                        of[j] = (short)(sb == r32 ? (last ? 0x3F80 : 0x4000) : ((last && sb + 1 == r32) ? 0x3F80 : 0)); }
                    im = __builtin_amdgcn_mfma_f32_32x32x16_bf16(of, pf[kk], im, 0, 0, 0);
#pragma unroll
                    for (int db = 0; db < 2; ++db) {
                        const s16x4 lo = vtr(vt + vo[db] + kk * 2048), hh = vtr(vt + vo[db] + kk * 2048 + 1024);
                        const bf16x8 vf = (bf16x8){lo[0], lo[1], lo[2], lo[3], hh[0], hh[1], hh[2], hh[3]};
                        o[db] = __builtin_amdgcn_mfma_f32_32x32x16_bf16(vf, pf[kk], o[db], 0, 0, 0);
                    }
                }
                __builtin_amdgcn_sched_barrier(0);
                if (hi == 0) {
                    im[0] += carry; carry = im[8];
#pragma unroll
                    for (int r = 0; r < 8; ++r) impw[16 * ct + (r & 3) + 8 * (r >> 2)] = im[r];
                    if (ct == nct - 1 && 16 * ct + 16 < 64) impw[16 * ct + 16] = im[8];
                } else {
#pragma unroll
                    for (int r = 0; r < 8; ++r) impw[16 * ct + 4 + (r & 3) + 8 * (r >> 2)] = im[r];
                }
            }
            if (ct + 1 < nct) st.store(lds + (cur ? L_K0 : L_K1), lds + (cur ? L_V0 : L_V1));
            __syncthreads();
        }
        if (pass == 0) l += __shfl_xor(l, 32);
        else oa_accum<true>(oap, o, g0, hi);
    }
    {
        const int tl = tid >> 3, sub = tid & 7, cur = qt;
        unsigned long long mask;
        if (cur + 1 <= 16) mask = (2ull << cur) - 1ull;
        else {
            float v[8];
            const ALAS float* ib = (const ALAS float*)(lds + L_IMP) + tl * 64 + sub * 8;
#pragma unroll
            for (int i = 0; i < 8; ++i) { const int s = sub * 8 + i; const float x = (ib[i] + ib[4096 + i]) + (ib[8192 + i] + ib[12288 + i]); v[i] = (s >= 1 && s <= cur - 2) ? x : -3e38f; }
            mask = 1ull | (1ull << cur) | (1ull << (cur - 1));
            for (int it = 0; it < 13; ++it) {
                float best = v[0]; int bi = 0;
#pragma unroll
                for (int i = 1; i < 8; ++i) if (v[i] > best) { best = v[i]; bi = i; }
                int bs = sub * 8 + bi;
#pragma unroll
                for (int off = 1; off < 8; off <<= 1) { const float ob = __shfl_xor(best, off); const int os = __shfl_xor(bs, off); if (ob > best || (ob == best && os < bs)) { best = ob; bs = os; } }
                if (best > -1e38f) { mask |= 1ull << bs;
#pragma unroll
                    for (int i = 0; i < 8; ++i) if (sub * 8 + i == bs) v[i] = -3e38f; }
            }
        }
        if (sub == 0) ((ALAS unsigned long long*)(lds + L_SELM))[tl] = mask;
        __syncthreads();
    }
    unsigned long long mymask = ((const ALAS unsigned long long*)(lds + L_SELM))[32 * th + r32];
    unsigned long long uni = 0ull;
    { const ALAS unsigned long long* sm = (const ALAS unsigned long long*)(lds + L_SELM);
      for (int i = 0; i < 64; ++i) uni |= sm[i]; }
    uni = ((unsigned long long)(unsigned)__builtin_amdgcn_readfirstlane((int)(uni >> 32)) << 32) | (unsigned)__builtin_amdgcn_readfirstlane((int)uni);
    {
        f32x16 o[2]; zero2(o); m = NEGB; l = 0.f;
        const ALAS float* tab = (const ALAS float*)(lds + L_TSEL) + h * TABN;
        st.init(P + (size_t)b * T * NP + C_KSLC, P + (size_t)b * T * NP + C_VSLC, NP, tid);
        unsigned long long rem = uni;
        int s = 63 - __builtin_clzll(rem); rem &= ~(1ull << s);
        st.load((size_t)(64 * s) * NP); st.store(lds + L_K0, lds + L_V0);
        __syncthreads();
        int cur = 0;
        for (;;) {
            const int sn = rem ? 63 - __builtin_clzll(rem) : -1;
            if (sn >= 0) { rem &= ~(1ull << sn); st.load((size_t)(64 * sn) * NP); }
            const bool mine = (mymask >> s) & 1ull;
            if (__any(mine)) {
                const ALAS char* kt = lds + (cur ? L_K1 : L_K0); const ALAS char* vt = lds + (cur ? L_V1 : L_V0);
                const int D0 = tq - 64 * s - 4 * hi;
                if (qt - s <= 7) tile_step<64, 1>(kt, vt, ko, vo, qf, c, 0.f, tab + (mine ? DMAXT - D0 : DMAXT + 1), m, l, o);
                else tile_step<64, 0>(kt, vt, ko, vo, qf, c, mine ? b31 : NEGB, tab, m, l, o);
            }
            if (sn >= 0) st.store(lds + (cur ? L_K0 : L_K1), lds + (cur ? L_V0 : L_V1));
            __syncthreads();
            if (sn < 0) break;
            s = sn; cur ^= 1;
        }
        l += __shfl_xor(l, 32);
        oa_accum<false>(oap, o, g1 / l, hi);
    }
    {
        f32x16 o[2]; zero2(o); m = NEGB; l = 0.f;
        const ALAS float* tab = (const ALAS float*)(lds + L_TWIN) + h * TABN;
        st.init(P + (size_t)b * T * NP + C_KWIN, P + (size_t)b * T * NP + C_VWIN, NP, tid);
        const int ntl = qt + 1 < 9 ? qt + 1 : 9;
        st.load((size_t)(64 * qt) * NP); st.store(lds + L_K0, lds + L_V0);
        __syncthreads();
        for (int i = 0; i < ntl; ++i) {
            const int cur = i & 1, jt = qt - i;
            if (i + 1 < ntl) st.load((size_t)(64 * (jt - 1)) * NP);
            { const int D0 = tq - 64 * jt - 4 * hi;
              tile_step<64, 1>(lds + (cur ? L_K1 : L_K0), lds + (cur ? L_V1 : L_V0), ko, vo, qf, c, 0.f, tab + (DMAXT - D0), m, l, o); }
            if (i + 1 < ntl) st.store(lds + (cur ? L_K0 : L_K1), lds + (cur ? L_V0 : L_V1));
            __syncthreads();
        }
        l += __shfl_xor(l, 32);
        oa_accum<false>(oap, o, g2 / l, hi);
    }
    { f32x16 acc[2];
#pragma unroll
      for (int db = 0; db < 2; ++db)
#pragma unroll
        for (int g = 0; g < 4; ++g) { const float4 v = *(const float4*)(oap + 32 * db + 8 * g + 4 * hi); acc[db][4 * g] = v.x; acc[db][4 * g + 1] = v.y; acc[db][4 * g + 2] = v.z; acc[db][4 * g + 3] = v.w; }
      store_mixed(p, acc, tok, 64 * h, hi); }
}
}

constexpr int SMEM_BYTES = 160 * 1024;
constexpr int PARAM_OFF = SMEM_BYTES - 256;
constexpr int VSMEM = 49152;

__global__ void __launch_bounds__(512, 2) mega(Params p0) {
    extern __shared__ __attribute__((aligned(16))) char smem[];
    cg::grid_group grid = cg::this_grid();
    if (threadIdx.x == 0) {
        ALAS unsigned long long* pl = (ALAS unsigned long long*)((ALAS char*)smem + PARAM_OFF);
#pragma unroll
        for (int i_ = 0; i_ < 14; ++i_) pl[i_] = (unsigned long long)p0.in[i_];
        pl[14] = (unsigned long long)p0.xout; pl[15] = (unsigned long long)p0.ws;
    }
    __syncthreads();
    const int wid_s = __builtin_amdgcn_readfirstlane((int)(threadIdx.x >> 6));
    for (int ph = 0; ph < 1 + 5 * DEPTH; ++ph) {
        int ph_ = ph; asm volatile("" : "+s"(ph_));
        int t_;
        { int w_ = wid_s; unsigned ones_ = ~0u; asm volatile("" : "+s"(w_), "+s"(ones_));
          t_ = w_ * 64 + (int)__builtin_amdgcn_mbcnt_hi(ones_, __builtin_amdgcn_mbcnt_lo(ones_, 0u)); }
        Params p;
        {
            unsigned poff_ = PARAM_OFF; asm volatile("" : "+v"(poff_));
            const ALAS unsigned* pl = (const ALAS unsigned*)((ALAS char*)smem + poff_);
#pragma unroll
            for (int i_ = 0; i_ < 16; ++i_) {
                const unsigned lo_ = (unsigned)__builtin_amdgcn_readfirstlane((int)pl[2 * i_]), hi_ = (unsigned)__builtin_amdgcn_readfirstlane((int)pl[2 * i_ + 1]);
                const unsigned long long v_ = ((unsigned long long)hi_ << 32) | lo_;
                if (i_ < 14) p.in[i_] = (const float*)v_; else if (i_ == 14) p.xout = (float*)v_; else p.ws = (char*)v_;
            }
        }
        int G = gridDim.x, bid = blockIdx.x; asm volatile("" : "+s"(G), "+s"(bid));
        const int NGW = G * 8;
        const int l = (ph_ - 1) / 5, k = ph_ == 0 ? -1 : (ph_ - 1) % 5;
        const int vh_ = t_ >> 8; char* vsm_ = smem + vh_ * VSMEM;
        if (k == -1) {
            pro_all(p, bid * 512 + t_, G * 512);
            for (int row = bid * 8 + (t_ >> 6); row < NTOK; row += NGW) pro_xrow(p, row, t_ & 63);
        } else if (k == 0) {
            pg8::Gemm g{((bf16_t*)(p.ws + WS_XB)), ((bf16_t*)(p.ws + WS_WTIN)) + (size_t)l * NP * D, NTOK, NP, D, D};
            pg8::StaticOrder S; S.init(NTOK, NP, G, bid);
            pg8::EpiInProj E{((bf16_t*)(p.ws + WS_P)), ((float*)(p.ws + WS_RS)), ((float*)(p.ws + WS_SSQQ)), ((float*)(p.ws + WS_SSQKV))};
            pg8::gemm_phase<pg8::EpiInProj, pg8::StaticOrder, true, true>(t_, (PG8_LAS unsigned char*)smem, g, S, E);
        } else if (k == 1) {
            for (int vb = 2 * bid + vh_; vb < 256 + NTOK / 8; vb += 2 * G) {
                if (vb < 256) b_compress(p, t_, l, vb & 31, (vb >> 5) & 1, vb >> 6, vsm_); else b_mla_up(p, t_, l, vb - 256, vsm_);
                __syncthreads();
            }
        } else if (k == 2) {
            ALAS char* L = (ALAS char*)smem;
            att::build_table((ALAS float*)(L + att::L_TAB), nullptr, 1 << 30, t_, 512);
            __syncthreads();
            for (int u = bid; u < 256; u += G) { const int qt = 15 - (u >> 4), bh = u & 15; int tt = t_; asm volatile("" : "+v"(tt)); att::mla_unit(p, tt, L, bh >> 2, bh & 3, qt); }
            __syncthreads();
            att::nsa_tables(p, t_, L);
            __syncthreads();
            for (int u = bid; u < 256; u += G) { int tt = t_; asm volatile("" : "+v"(tt)); att::nsa_unit(p, tt, L, u & 3, u >> 2); }
            __syncthreads();
            for (int hh = 0; hh < 8; ++hh) att::build_table((ALAS float*)(L + att::L_TAB) + hh * att::TABN, (const float*)(p.ws + WS_BTAB) + (4 + hh) * BT_STRIDE, 128, t_, 512);
            __syncthreads();
            for (int u = bid; u < 512; u += G) { int tt = t_; asm volatile("" : "+v"(tt)); att::swa_unit(p, tt, L, l, u & 3, u >> 2); }
        } else if (k == 3) {
            pg8::Gemm g{((bf16_t*)(p.ws + WS_MIX)), ((bf16_t*)(p.ws + WS_WTOUT)) + (size_t)l * D * D, NTOK, D, D, D};
            pg8::StaticOrder S; S.init(NTOK, D, G, bid);
            pg8::EpiF32 E{((float*)(p.ws + WS_P)), D};
            pg8::gemm_phase<pg8::EpiF32, pg8::StaticOrder, true, true>(t_, (PG8_LAS unsigned char*)smem, g, S, E);
        } else {
            for (int row = bid * 8 + (t_ >> 6); row < NTOK; row += NGW) post_row(p, l, row, t_ & 63);
        }
        grid.sync();
    }
}

extern "C" void kernel_launch(void* const* d_in, const int* in_sizes, int n_in, void* d_out, int out_size, void* d_ws, size_t ws_size, hipStream_t stream) {
    Params p{};
    for (int i = 0; i < 14; ++i) p.in[i] = (const float*)d_in[i];
    p.xout = (float*)d_out; p.ws = (char*)d_ws;
    const size_t off = WS_END;
    static int grid_blocks = 0;
    if (!grid_blocks) {
        int dev = 0, cus = 0, per_cu = 0;
        (void)hipGetDevice(&dev);
        (void)hipDeviceGetAttribute(&cus, hipDeviceAttributeMultiprocessorCount, dev);
        (void)hipFuncSetAttribute((const void*)mega, hipFuncAttributeMaxDynamicSharedMemorySize, SMEM_BYTES);
        (void)hipOccupancyMaxActiveBlocksPerMultiprocessor(&per_cu, (const void*)mega, 512, SMEM_BYTES);
        if (per_cu < 1) fprintf(stderr, "occupancy query says %d blocks per CU\n", per_cu);
        grid_blocks = cus;
        if (off > ws_size) fprintf(stderr, "workspace too small: need %zu have %zu\n", off, ws_size);
    }
    void* args[] = {&p};
    hipError_t e = hipLaunchCooperativeKernel((void*)mega, dim3(grid_blocks), dim3(512), args, SMEM_BYTES, stream);
    if (e != hipSuccess) fprintf(stderr, "cooperative launch failed: %s (grid %d)\n", hipGetErrorString(e), grid_blocks);
}
```

```cpp
#include <hip/hip_runtime.h>
#include <hip/hip_cooperative_groups.h>
#include <stdint.h>
#include <cstdio>
namespace cg = cooperative_groups;

typedef unsigned short bf16_t;
#define DI __device__ __forceinline__

DI float bf2f(bf16_t v) { return __uint_as_float(((unsigned)v) << 16); }
DI bf16_t f2bf(float f) { unsigned u = __float_as_uint(f); u += 0x7fffu + ((u >> 16) & 1u); return (bf16_t)(u >> 16); }
DI float bflo(unsigned w) { return __uint_as_float(w << 16); }
DI float bfhi(unsigned w) { return __uint_as_float(w & 0xffff0000u); }
DI unsigned pk2(float lo, float hi) { return (unsigned)f2bf(lo) | ((unsigned)f2bf(hi) << 16); }

constexpr int NB = 4, T = 4096, D = 1024, NTOK = NB * T, DEPTH = 4, DIN = 2732, NP = 2816;
constexpr int C_AQ = 0, C_KCMP = 256, C_VCMP = 320, C_KSLC = 384, C_VSLC = 448, C_KWIN = 512, C_VWIN = 576, C_CK = 640, C_CV = 704;
constexpr int C_BCQ = 768, C_BCKV = 1024, C_BKR = 1152, C_AG = 1184, C_CQ = 1280, C_Z = 1792;
constexpr int BT_STRIDE = 520;

__host__ __device__ inline int src_col(int n) {
    if (n < 640) return n;
    if (n < 768) return 1580 + (n - 640);
    if (n < 1024) return 652 + (n - 768);
    if (n < 1152) return 908 + (n - 1024);
    if (n < 1184) return 1036 + (n - 1152);
    if (n < 1196) return 640 + (n - 1184);
    if (n < 1280) return -1;
    if (n < 1792) return 1068 + (n - 1280);
    return 1708 + (n - 1792);
}

DI int t5_bucket(int d) {
    if (d < 16) return d < 0 ? 0 : d;
    int b = 16;
    b += d >= 20; b += d >= 25; b += d >= 31; b += d >= 39; b += d >= 48; b += d >= 59; b += d >= 73; b += d >= 91;
    b += d >= 113; b += d >= 140; b += d >= 174; b += d >= 216; b += d >= 268; b += d >= 332; b += d >= 413;
    return b;
}

constexpr size_t al256(size_t x) { return (x + 255) & ~(size_t)255; }
constexpr size_t WS_P = 0;
constexpr size_t WS_XB = WS_P + al256((size_t)NTOK * NP * 2 + 65536);
constexpr size_t WS_WTIN = WS_XB + al256((size_t)NTOK * D * 2);
constexpr size_t WS_WTOUT = WS_WTIN + al256((size_t)DEPTH * NP * D * 2);
constexpr size_t WS_QM = WS_WTOUT + al256((size_t)DEPTH * D * D * 2);
constexpr size_t WS_KM = WS_QM + al256((size_t)NTOK * 384 * 2);
constexpr size_t WS_VM = WS_KM + al256((size_t)NTOK * 384 * 2);
constexpr size_t WS_MIX = WS_VM + al256((size_t)NTOK * 256 * 2);
constexpr size_t WS_OA = WS_MIX + al256((size_t)NTOK * 1024 * 2);
constexpr size_t WS_RS = WS_OA + al256((size_t)NTOK * 256 * 4);
constexpr size_t WS_SSQQ = WS_RS + al256((size_t)NTOK * 4);
constexpr size_t WS_SSQKV = WS_SSQQ + al256((size_t)NTOK * 16);
constexpr size_t WS_KC = WS_SSQKV + al256((size_t)NTOK * 16);
constexpr size_t WS_VC = WS_KC + al256((size_t)NB * 256 * 64 * 4);
constexpr size_t WS_SEL = WS_VC + al256((size_t)NB * 256 * 64 * 4);
constexpr size_t WS_BTAB = WS_SEL + al256((size_t)NTOK * 8);
constexpr size_t WS_WUQ = WS_BTAB + al256((size_t)12 * BT_STRIDE * 4);
constexpr size_t WS_WUKV = WS_WUQ + al256((size_t)DEPTH * 512 * 256 * 2);
constexpr size_t WS_W1T = WS_WUKV + al256((size_t)DEPTH * 512 * 128 * 2);
constexpr size_t WS_W2T = WS_W1T + al256((size_t)DEPTH * 2 * 128 * 2048 * 2);
constexpr size_t WS_BVEC = WS_W2T + al256((size_t)DEPTH * 2 * 64 * 128 * 2);
constexpr size_t WS_ROPE = WS_BVEC + al256((size_t)DEPTH * 2 * 128 * 4);
constexpr size_t WS_END = WS_ROPE + al256((size_t)T * 16 * 8);

struct Params {
    const float* in[14]; float* xout; char* ws;
#define PF(name, idx) DI const float* name() const { return in[idx]; }
    PF(x_in_, 0) PF(w_in_, 1) PF(w_out_, 2) PF(norm_pre_, 3) PF(norm_post_, 4) PF(cmp_pos_, 5) PF(cmp_w1_, 6) PF(cmp_w2_, 7) PF(q_norm_, 8) PF(w_uq_, 9) PF(kv_norm_, 10) PF(w_ukv_, 11) PF(sinks_, 12) PF(rel_bias_, 13)
#undef PF
};
#define x_in x_in_()
#define w_in w_in_()
#define w_out w_out_()
#define norm_pre norm_pre_()
#define norm_post norm_post_()
#define cmp_pos cmp_pos_()
#define cmp_w1 cmp_w1_()
#define cmp_w2 cmp_w2_()
#define q_norm q_norm_()
#define w_uq w_uq_()
#define kv_norm kv_norm_()
#define w_ukv w_ukv_()
#define sinks sinks_()
#define rel_bias rel_bias_()

namespace pg8 {
#define PG8_LAS __attribute__((address_space(3)))
typedef short bf16x8 __attribute__((ext_vector_type(8)));
typedef float f32x4 __attribute__((ext_vector_type(4)));
typedef unsigned u32x4 __attribute__((ext_vector_type(4)));
constexpr int BM = 256, BK = 64, HALF = 128, HTB = HALF * BK * 2  , STAGE_BYTES = 8 * HTB, NXCD = 8, WGM = 8;

__host__ __device__ __forceinline__ int lds_byte(int r, int c) { const int st = (r >> 4) * 2 + (c >> 5), rr = r & 15, cc = c & 31, ob = rr * 64 + cc * 2; return st * 1024 + (ob ^ (((ob >> 9) & 1) << 5)); }
__host__ __device__ __forceinline__ void stage_rc(int b, int& R, int& C) { const int st = b / 1024, sb = b % 1024, swz = sb ^ (((sb >> 9) & 1) << 5); R = (st >> 1) * 16 + swz / 64; C = (st & 1) * 32 + (swz % 64) / 2; }
__host__ __device__ __forceinline__ int perm32(int rho) { const int n = rho >> 4, i = rho & 15; return 8 * (i >> 2) + 4 * n + (i & 3); }

struct Unit { int pm, pn; };
struct Gemm { const bf16_t* A; const bf16_t* Bt; int M, N, K, lda; };

struct StaticOrder {
    int nM, nN, nwg, G, c;
    __host__ __device__ void init(int M, int N, int G_, int c_) { nM = M / BM; nN = N / BM; nwg = nM * nN; G = G_; c = c_; }
    __host__ __device__ bool next(int i, Unit& u) const {
        const long L = (long)i * G + c; if (L >= nwg) return false;
        int wgid = (int)L; { const int q = nwg / NXCD, r = nwg % NXCD, xcd = wgid % NXCD, off = wgid / NXCD; wgid = (xcd < r ? xcd * (q + 1) : r * (q + 1) + (xcd - r) * q) + off; }
        const int nig = WGM * nN, gid = wgid / nig, fm = gid * WGM, gsz = (nM - fm) < WGM ? (nM - fm) : WGM;
        u.pm = fm + ((wgid % nig) % gsz); u.pn = (wgid % nig) / gsz; return true;
    }
    __device__ __forceinline__ void a_ready(const Unit&) const {}
    __device__ __forceinline__ void done(const Unit&) const {}
};

template <class Epi, class Sched, bool ALIGN_EPI = false, bool SP2 = false>
__device__ __forceinline__ void gemm_phase(const int tid, PG8_LAS unsigned char* lds, const Gemm g, const Sched& S, const Epi& E) {
    const int wid = __builtin_amdgcn_readfirstlane(tid >> 6), lane = tid & 63, wr = wid >> 2, wc = wid & 3, fr = lane & 15, fq = lane >> 4;
    const int K = g.K, nt = K / BK, lda = g.lda;
    unsigned voffA, voffB;
    { int R, C; stage_rc(tid * 16, R, C); const int Rb = Epi::PERM ? ((R & ~31) + perm32(R & 31)) : R;
      voffA = (unsigned)(R * lda + C) * 2u; voffB = (unsigned)(Rb * K + C) * 2u; }
    const size_t pvoffA = (size_t)64 * lda * 2, pvoffB = (size_t)64 * K * 2;
    const size_t kstep = (size_t)(BK * 2);
    const size_t hstepA = (size_t)HALF * lda * 2, hstepB = (size_t)HALF * K * 2;
    const size_t tstepA = 2 * hstepA, tstepB = 2 * hstepB;
    const unsigned ldsw = (unsigned)wid * 1024u;
    const int aoff = lds_byte(wr * 64 + fr, fq * 8), boff = lds_byte(wc * 32 + fr, fq * 8);
#define PG8_SA(b, h) (((b) * 2 + (h)) * HTB)
#define PG8_SB(b, h) ((4 + (b) * 2 + (h)) * HTB)
#define PG8_STAGE(bufoff, gbase, voff) do { _Pragma("unroll") for (int _i = 0; _i < 2; ++_i) \
        __builtin_amdgcn_global_load_lds((const unsigned*)((const char*)(gbase) + _i * p##voff + (voff)), (PG8_LAS unsigned*)(lds + (bufoff) + ldsw + _i * 8192), 16, 0, 0); } while (0)
#define PG8_LDA(dst, b, h) do { _Pragma("unroll") for (int m = 0; m < 4; ++m) _Pragma("unroll") for (int k = 0; k < 2; ++k) dst[m][k] = *(const PG8_LAS bf16x8*)(lds + PG8_SA(b, h) + aoff + m * 2048 + k * 1024); } while (0)
#define PG8_LDB(dst, b, h) do { _Pragma("unroll") for (int n = 0; n < 2; ++n) _Pragma("unroll") for (int k = 0; k < 2; ++k) dst[n][k] = *(const PG8_LAS bf16x8*)(lds + PG8_SB(b, h) + boff + n * 2048 + k * 1024); } while (0)
#define PG8_MMA(ai, bj, At, Bt) do { __builtin_amdgcn_s_setprio(1); _Pragma("unroll") for (int m = 0; m < 4; ++m) _Pragma("unroll") for (int n = 0; n < 2; ++n) _Pragma("unroll") for (int k = 0; k < 2; ++k) \
        acc[ai][bj][m][n] = __builtin_amdgcn_mfma_f32_16x16x32_bf16(Bt[n][k], At[m][k], acc[ai][bj][m][n], 0, 0, 0); __builtin_amdgcn_s_setprio(0); } while (0)
#define PG8_WAIT_V(n) asm volatile("s_waitcnt vmcnt(" #n ")" ::: "memory")
#define PG8_WAIT_L(n) asm volatile("s_waitcnt lgkmcnt(" #n ")" ::: "memory")
#define PG8_BAR __builtin_amdgcn_s_barrier()
#define PG8_SCHED __builtin_amdgcn_sched_barrier(0)
    Unit cur, nxt; int ui = 0;
    if (!S.next(0, cur)) return;
    f32x4 acc[2][2][4][2];
#pragma unroll
    for (int a = 0; a < 2; ++a)
#pragma unroll
        for (int b = 0; b < 2; ++b)
#pragma unroll
            for (int m = 0; m < 4; ++m)
#pragma unroll
                for (int n = 0; n < 2; ++n) acc[a][b][m][n] = (f32x4){0.f, 0.f, 0.f, 0.f};
    bf16x8 At[4][2], B0[2][2], B1[2][2];
    const char* cA = (const char*)g.A + (size_t)cur.pm * tstepA; const char* cB = (const char*)g.Bt + (size_t)cur.pn * tstepB;
    S.a_ready(cur);
    if constexpr (SP2) {
        PG8_STAGE(PG8_SB(0, 0), cB, voffB); PG8_STAGE(PG8_SB(0, 1), cB + hstepB, voffB); PG8_STAGE(PG8_SA(0, 0), cA, voffA); PG8_STAGE(PG8_SA(0, 1), cA + hstepA, voffA);
        if (wr == 1) PG8_BAR;
        PG8_WAIT_V(2); PG8_BAR;
        PG8_STAGE(PG8_SB(1, 0), cB + kstep, voffB); PG8_STAGE(PG8_SA(1, 0), cA + kstep, voffA); PG8_STAGE(PG8_SB(1, 1), cB + hstepB + kstep, voffB);
        PG8_WAIT_V(6); PG8_BAR;
    } else {
        PG8_STAGE(PG8_SB(0, 0), cB, voffB); PG8_STAGE(PG8_SA(0, 0), cA, voffA); PG8_STAGE(PG8_SB(0, 1), cB + hstepB, voffB); PG8_STAGE(PG8_SA(0, 1), cA + hstepA, voffA);
        if (wr == 1) PG8_BAR;
        PG8_WAIT_V(4); PG8_BAR;
        PG8_STAGE(PG8_SB(1, 0), cB + kstep, voffB); PG8_STAGE(PG8_SA(1, 0), cA + kstep, voffA); PG8_STAGE(PG8_SB(1, 1), cB + hstepB + kstep, voffB);
        PG8_WAIT_V(6); PG8_BAR;
    }
    for (;;) {
        const bool has_next = S.next(ui + 1, nxt);
        const char* nA = has_next ? (const char*)g.A + (size_t)nxt.pm * tstepA : cA; const char* nB = has_next ? (const char*)g.Bt + (size_t)nxt.pn * tstepB : cB;
        for (int t = 0; t < nt; t += 2) {
            const bool last = (t == nt - 2);
            const char* a1 = cA + (size_t)(t + 1) * kstep;
            const char* a2 = last ? nA : cA + (size_t)(t + 2) * kstep; const char* b2 = last ? nB : cB + (size_t)(t + 2) * kstep;
            const char* a3 = a2 + kstep; const char* b3 = b2 + kstep;
            if (last && has_next) S.a_ready(nxt);
            if constexpr (SP2) {
            PG8_LDB(B0, 0, 0); PG8_LDB(B1, 0, 1); PG8_SCHED; PG8_LDA(At, 0, 0); PG8_STAGE(PG8_SA(1, 1), a1 + hstepA, voffA);
            PG8_WAIT_V(8); PG8_WAIT_L(0); PG8_BAR; PG8_MMA(0, 0, At, B0); PG8_MMA(0, 1, At, B1); PG8_BAR; PG8_SCHED;
            PG8_LDA(At, 0, 1); PG8_STAGE(PG8_SB(0, 0), b2, voffB); PG8_STAGE(PG8_SB(0, 1), b2 + hstepB, voffB); PG8_STAGE(PG8_SA(0, 0), a2, voffA);
            PG8_WAIT_V(8); PG8_WAIT_L(0); PG8_BAR; PG8_MMA(1, 0, At, B0); PG8_MMA(1, 1, At, B1); PG8_BAR; PG8_SCHED;
            PG8_LDB(B0, 1, 0); PG8_LDB(B1, 1, 1); PG8_SCHED; PG8_LDA(At, 1, 0); PG8_STAGE(PG8_SA(0, 1), a2 + hstepA, voffA);
            PG8_WAIT_V(8); PG8_WAIT_L(0); PG8_BAR; PG8_MMA(0, 0, At, B0); PG8_MMA(0, 1, At, B1); PG8_BAR; PG8_SCHED;
            PG8_LDA(At, 1, 1); PG8_STAGE(PG8_SB(1, 0), b3, voffB); PG8_STAGE(PG8_SB(1, 1), b3 + hstepB, voffB); PG8_STAGE(PG8_SA(1, 0), a3, voffA);
            PG8_WAIT_V(8); PG8_WAIT_L(0); PG8_BAR; PG8_MMA(1, 0, At, B0); PG8_MMA(1, 1, At, B1); PG8_BAR; PG8_SCHED;
            } else {
            PG8_LDB(B0, 0, 0); PG8_SCHED; PG8_LDA(At, 0, 0); PG8_STAGE(PG8_SA(1, 1), a1 + hstepA, voffA);
            PG8_WAIT_L(8); PG8_BAR; PG8_WAIT_L(0); PG8_MMA(0, 0, At, B0); PG8_BAR; PG8_SCHED;
            PG8_LDB(B1, 0, 1); PG8_STAGE(PG8_SB(0, 0), b2, voffB);
            PG8_BAR; PG8_WAIT_L(0); PG8_MMA(0, 1, At, B1); PG8_BAR;
            PG8_LDA(At, 0, 1); PG8_STAGE(PG8_SA(0, 0), a2, voffA);
            PG8_BAR; PG8_WAIT_L(0); PG8_MMA(1, 0, At, B0); PG8_BAR; PG8_SCHED;
            PG8_STAGE(PG8_SB(0, 1), b2 + hstepB, voffB);
            PG8_WAIT_V(6); PG8_BAR; PG8_MMA(1, 1, At, B1); PG8_BAR;
            PG8_LDB(B0, 1, 0); PG8_SCHED; PG8_LDA(At, 1, 0); PG8_STAGE(PG8_SA(0, 1), a2 + hstepA, voffA);
            PG8_WAIT_L(8); PG8_BAR; PG8_WAIT_L(0); PG8_MMA(0, 0, At, B0); PG8_BAR; PG8_SCHED;
            PG8_LDB(B1, 1, 1); PG8_STAGE(PG8_SB(1, 0), b3, voffB);
            PG8_BAR; PG8_WAIT_L(0); PG8_MMA(0, 1, At, B1); PG8_BAR;
            PG8_LDA(At, 1, 1); PG8_STAGE(PG8_SA(1, 0), a3, voffA);
            PG8_BAR; PG8_WAIT_L(0); PG8_MMA(1, 0, At, B0); PG8_BAR; PG8_SCHED;
            PG8_STAGE(PG8_SB(1, 1), b3 + hstepB, voffB);
            PG8_WAIT_V(6); PG8_BAR; PG8_MMA(1, 1, At, B1); PG8_BAR;
            }
        }
        if constexpr (ALIGN_EPI) { if (wr == 0) PG8_BAR; }
        if constexpr (!Epi::AFTER_DRAIN) {
            unsigned ones_ = ~0u; asm volatile("" : "+s"(ones_)); const int ln_ = (int)__builtin_amdgcn_mbcnt_hi(ones_, __builtin_amdgcn_mbcnt_lo(ones_, 0u));
            E(acc, cur, wr, wc, ln_ & 15, ln_ >> 4); S.done(cur); }
        if (!has_next) break;
#pragma unroll
        for (int a = 0; a < 2; ++a)
#pragma unroll
            for (int b = 0; b < 2; ++b)
#pragma unroll
                for (int m = 0; m < 4; ++m)
#pragma unroll
                    for (int n = 0; n < 2; ++n) acc[a][b][m][n] = (f32x4){0.f, 0.f, 0.f, 0.f};
        cur = nxt; cA = nA; cB = nB; ++ui;
        if constexpr (ALIGN_EPI) { if (wr == 1) PG8_BAR; }
    }
    PG8_WAIT_V(0);
    if constexpr (!ALIGN_EPI) { if (wr == 0) PG8_BAR; }
    PG8_BAR;
    if constexpr (Epi::AFTER_DRAIN) { E.fused(acc, cur, wr, wc, fr, fq, lds, wid, lane); S.done(cur); }
#undef PG8_SA
#undef PG8_SB
#undef PG8_STAGE
#undef PG8_LDA
#undef PG8_LDB
#undef PG8_MMA
#undef PG8_WAIT_V
#undef PG8_WAIT_L
#undef PG8_BAR
#undef PG8_SCHED
}

struct EpiInProj {
    static constexpr bool PERM = true, AFTER_DRAIN = false;
    bf16_t* O; const float* rs; float* ssq_q; float* ssq_kv;
    __device__ __forceinline__ void operator()(const f32x4 (&acc)[2][2][4][2], const Unit& u, int wr, int wc, int fr, int fq) const {
        const int row0 = u.pm * BM + wr * 64 + fr, col0 = u.pn * BM + wc * 32 + 8 * fq;
#pragma unroll
        for (int ai = 0; ai < 2; ++ai)
#pragma unroll
            for (int m = 0; m < 4; ++m) {
                const int row = row0 + ai * HALF + m * 16; const float r = rs[row];
                bf16_t* rowp = O + (size_t)row * NP + col0; float ss[2];
#pragma unroll
                for (int bj = 0; bj < 2; ++bj) { const f32x4 v0 = acc[ai][bj][m][0] * r, v1 = acc[ai][bj][m][1] * r;
                    u32x4 w; w.x = pk2(v0[0], v0[1]); w.y = pk2(v0[2], v0[3]); w.z = pk2(v1[0], v1[1]); w.w = pk2(v1[2], v1[3]);
                    *(u32x4*)(rowp + bj * HALF) = w;
                    ss[bj] = (v0[0] * v0[0] + v0[1] * v0[1]) + (v0[2] * v0[2] + v0[3] * v0[3]) + (v1[0] * v1[0] + v1[1] * v1[1]) + (v1[2] * v1[2] + v1[3] * v1[3]); }
                if (u.pn == 3 || u.pn == 4) {
                    float s = u.pn == 3 ? ss[0] + ss[1] : ss[0];
                    s += __shfl_xor(s, 16); s += __shfl_xor(s, 32);
                    if (fq == 0) ((u.pn == 3 ? ssq_q : ssq_kv) + (size_t)row * 4)[wc] = s;
                }
            }
    }
};
struct EpiF32 {
    static constexpr bool PERM = false, AFTER_DRAIN = false;
    float* O; int ldc;
    __device__ __forceinline__ void operator()(const f32x4 (&acc)[2][2][4][2], const Unit& u, int wr, int wc, int fr, int fq) const {
        const int row0 = u.pm * BM + wr * 64 + fr, col0 = u.pn * BM + wc * 32 + 4 * fq;
#pragma unroll
        for (int ai = 0; ai < 2; ++ai)
#pragma unroll
            for (int m = 0; m < 4; ++m) { float* rowp = O + (size_t)(row0 + ai * HALF + m * 16) * ldc + col0;
#pragma unroll
                for (int bj = 0; bj < 2; ++bj)
#pragma unroll
                    for (int n = 0; n < 2; ++n) *(f32x4*)(rowp + bj * HALF + n * 16) = acc[ai][bj][m][n]; }
    }
};
struct EpiQ {
    static constexpr bool PERM = true, AFTER_DRAIN = false;
    bf16_t* Qm; const float* ssq; const float2* rope;
    __device__ __forceinline__ void operator()(const f32x4 (&acc)[2][2][4][2], const Unit& u, int wr, int wc, int fr, int fq) const {
        const int row0 = u.pm * BM + wr * 64 + fr;
#pragma unroll
        for (int ai = 0; ai < 2; ++ai)
#pragma unroll
            for (int m = 0; m < 4; ++m) {
                const int row = row0 + ai * HALF + m * 16;
                const f32x4 sq = *(const f32x4*)(ssq + (size_t)row * 4);
                const float r = rsqrtf(((sq[0] + sq[1]) + (sq[2] + sq[3])) * (1.f / 256.f) + 1e-6f);
#pragma unroll
                for (int bj = 0; bj < 2; ++bj) {
                    const int j0 = u.pn * BM + bj * HALF + wc * 32 + 8 * fq;
                    if (u.pn * BM + bj * HALF >= 384) continue;
                    float v[8];
#pragma unroll
                    for (int t = 0; t < 4; ++t) { v[t] = acc[ai][bj][m][0][t] * r; v[4 + t] = acc[ai][bj][m][1][t] * r; }
                    if (((j0 >> 5) % 3) == 2) {
                        const float2* cs = rope + (size_t)(row & (T - 1)) * 16 + 8 * (fq & 1);
#pragma unroll
                        for (int t = 0; t < 8; ++t) { const float o = __shfl_xor(v[t], 32); const float2 c2 = cs[t]; v[t] = fq < 2 ? v[t] * c2.x - o * c2.y : v[t] * c2.x + o * c2.y; }
                    }
                    u32x4 w; w.x = pk2(v[0], v[1]); w.y = pk2(v[2], v[3]); w.z = pk2(v[4], v[5]); w.w = pk2(v[6], v[7]);
                    *(u32x4*)(Qm + (size_t)row * 384 + j0) = w;
                }
            }
    }
};
struct EpiKV {
    static constexpr bool PERM = true, AFTER_DRAIN = false;
    bf16_t* Km; bf16_t* Vm; const float* ssq;
    __device__ __forceinline__ void operator()(const f32x4 (&acc)[2][2][4][2], const Unit& u, int wr, int wc, int fr, int fq) const {
        const int row0 = u.pm * BM + wr * 64 + fr;
#pragma unroll
        for (int ai = 0; ai < 2; ++ai)
#pragma unroll
            for (int m = 0; m < 4; ++m) {
                const int row = row0 + ai * HALF + m * 16;
                const f32x4 sq = *(const f32x4*)(ssq + (size_t)row * 4);
                const float r = rsqrtf(((sq[0] + sq[1]) + (sq[2] + sq[3])) * (1.f / 128.f) + 1e-6f);
#pragma unroll
                for (int bj = 0; bj < 2; ++bj) {
                    const int j0 = u.pn * BM + bj * HALF + wc * 32 + 8 * fq, h = j0 >> 7, e = j0 & 127;
                    const f32x4 v0 = acc[ai][bj][m][0] * r, v1 = acc[ai][bj][m][1] * r;
                    u32x4 w; w.x = pk2(v0[0], v0[1]); w.y = pk2(v0[2], v0[3]); w.z = pk2(v1[0], v1[1]); w.w = pk2(v1[2], v1[3]);
                    if (e < 64) *(u32x4*)(Km + (size_t)row * 384 + h * 96 + e) = w; else *(u32x4*)(Vm + (size_t)row * 256 + h * 64 + (e - 64)) = w;
                }
            }
    }
};
}

template <class ColFn>
DI void transpose_tile(const float* W, int ldw, const float* g, bf16_t* dst, int ldd, int n0, int k0, ColFn colfn, int tid, float* tile  ) {
    { const int k = tid >> 3, n8 = (tid & 7) * 8; const float gg = g ? g[k0 + k] : 1.f;
#pragma unroll
      for (int j = 0; j < 8; ++j) { const int sc = colfn(n0 + n8 + j); tile[k * 65 + n8 + j] = sc >= 0 ? W[(size_t)(k0 + k) * ldw + sc] * gg : 0.f; } }
    __syncthreads();
    { const int n = tid >> 3, k8 = (tid & 7) * 8; float v[8];
#pragma unroll
      for (int j = 0; j < 8; ++j) v[j] = tile[(k8 + j) * 65 + n];
      uint4 w; w.x = pk2(v[0], v[1]); w.y = pk2(v[2], v[3]); w.z = pk2(v[4], v[5]); w.w = pk2(v[6], v[7]);
      *(uint4*)(dst + (size_t)(n0 + n) * ldd + k0 + k8) = w; }
    __syncthreads();
}
struct ColIdent { int lim; DI int operator()(int n) const { return n < lim ? n : -1; } };
struct ColIn { DI int operator()(int n) const { return src_col(n); } };
DI void pro_weights(const Params& p, int bid, int G, int tid, char* smem) {
    float* tile = (float*)smem;
    constexpr int T_IN = DEPTH * (NP / 64) * (D / 64), T_OUT = DEPTH * (D / 64) * (D / 64), T_UQ = DEPTH * 8 * 4, T_UKV = DEPTH * 8 * 2, T_W1 = DEPTH * 2 * 2 * 32, T_W2 = DEPTH * 2 * 1 * 2;
    for (int it = bid; it < T_IN + T_OUT + T_UQ + T_UKV + T_W1 + T_W2; it += G) {
        int r = it;
        if (r < T_IN) { const int l = r / ((NP / 64) * 16), q = r % ((NP / 64) * 16), nt = q / 16, kt = q % 16;
            transpose_tile(p.w_in + (size_t)l * D * DIN, DIN, p.norm_pre + l * D, (bf16_t*)(p.ws + WS_WTIN) + (size_t)l * NP * D, D, nt * 64, kt * 64, ColIn{}, tid, tile); continue; } r -= T_IN;
        if (r < T_OUT) { const int l = r / 256, q = r % 256, nt = q / 16, kt = q % 16;
            transpose_tile(p.w_out + (size_t)l * D * D, D, nullptr, (bf16_t*)(p.ws + WS_WTOUT) + (size_t)l * D * D, D, nt * 64, kt * 64, ColIdent{D}, tid, tile); continue; } r -= T_OUT;
        if (r < T_UQ) { const int l = r / 32, q = r % 32, nt = q / 4, kt = q % 4;
            transpose_tile(p.w_uq + (size_t)l * 256 * 384, 384, p.q_norm + l * 256, (bf16_t*)(p.ws + WS_WUQ) + (size_t)l * 512 * 256, 256, nt * 64, kt * 64, ColIdent{384}, tid, tile); continue; } r -= T_UQ;
        if (r < T_UKV) { const int l = r / 16, q = r % 16, nt = q / 2, kt = q % 2;
            transpose_tile(p.w_ukv + (size_t)l * 128 * 512, 512, p.kv_norm + l * 128, (bf16_t*)(p.ws + WS_WUKV) + (size_t)l * 512 * 128, 128, nt * 64, kt * 64, ColIdent{512}, tid, tile); continue; } r -= T_UKV;
        if (r < T_W1) { const int lw = r / 64, q = r % 64, nt = q / 32, kt = q % 32;
            transpose_tile(p.cmp_w1 + (size_t)lw * 2048 * 128, 128, nullptr, (bf16_t*)(p.ws + WS_W1T) + (size_t)lw * 128 * 2048, 2048, nt * 64, kt * 64, ColIdent{128}, tid, tile); continue; } r -= T_W1;
        { const int lw = r / 2, kt = r % 2;
            transpose_tile(p.cmp_w2 + (size_t)lw * 128 * 64, 64, nullptr, (bf16_t*)(p.ws + WS_W2T) + (size_t)lw * 64 * 128, 128, 0, kt * 64, ColIdent{64}, tid, tile); }
    }
}
DI void pro_all(const Params& p, int gtid, int gsize) {
    for (int i = gtid; i < 12 * BT_STRIDE; i += gsize) { const int h = i / BT_STRIDE, d = i % BT_STRIDE; ((float*)(p.ws + WS_BTAB))[i] = p.rel_bias[h * 32 + t5_bucket(d)]; }
    for (int i = gtid; i < T * 16; i += gsize) { const int pos = i >> 4, k = i & 15; const float ang = (float)pos * powf(10000.0f, -(float)k / 16.0f); ((float2*)(p.ws + WS_ROPE))[i] = make_float2(cosf(ang), sinf(ang)); }
    for (int i = gtid; i < DEPTH * 2 * 128; i += gsize) { const int lw = i >> 7, n = i & 127; const float* pe = p.cmp_pos + (size_t)lw * 2048; const float* w1 = p.cmp_w1 + (size_t)lw * 2048 * 128 + n;
        float a = 0.f; for (int k = 0; k < 2048; ++k) a += pe[k] * w1[(size_t)k * 128]; ((float*)(p.ws + WS_BVEC))[i] = a; }
}
DI void pro_xrow(const Params& p, int row, int lane) {
    const float4* xp = (const float4*)(p.x_in + (size_t)row * D);
    float s = 0.f;
#pragma unroll
    for (int i = 0; i < 4; ++i) { const float4 v = xp[lane + 64 * i]; s += v.x * v.x + v.y * v.y + v.z * v.z + v.w * v.w;
        uint2 w; w.x = pk2(v.x, v.y); w.y = pk2(v.z, v.w); ((uint2*)(((bf16_t*)(p.ws + WS_XB)) + (size_t)row * D))[lane + 64 * i] = w; }
    for (int o = 32; o > 0; o >>= 1) s += __shfl_xor(s, o);
    if (lane == 0) ((float*)(p.ws + WS_RS))[row] = rsqrtf(s * (1.0f / D) + 1e-6f);
}
DI void post_row(const Params& p, int layer, int row, int lane) {
    const float* x = (layer == 0 ? p.x_in : p.xout) + (size_t)row * D;
    const float* y = ((float*)(p.ws + WS_P)) + (size_t)row * D;
    const float* g = p.norm_post + layer * D;
    float4 yv[4]; float s = 0.f;
#pragma unroll
    for (int i = 0; i < 4; ++i) { yv[i] = ((const float4*)y)[lane + 64 * i]; s += yv[i].x * yv[i].x + yv[i].y * yv[i].y + yv[i].z * yv[i].z + yv[i].w * yv[i].w; }
    for (int o = 32; o > 0; o >>= 1) s += __shfl_xor(s, o);
    const float r = rsqrtf(s * (1.f / D) + 1e-6f);
    float s2 = 0.f;
#pragma unroll
    for (int i = 0; i < 4; ++i) {
        const float4 xv = ((const float4*)x)[lane + 64 * i], gv = ((const float4*)g)[lane + 64 * i];
        float4 o; o.x = xv.x + yv[i].x * r * gv.x; o.y = xv.y + yv[i].y * r * gv.y; o.z = xv.z + yv[i].z * r * gv.z; o.w = xv.w + yv[i].w * r * gv.w;
        ((float4*)(p.xout + (size_t)row * D))[lane + 64 * i] = o;
        uint2 w; w.x = pk2(o.x, o.y); w.y = pk2(o.z, o.w); ((uint2*)(((bf16_t*)(p.ws + WS_XB)) + (size_t)row * D))[lane + 64 * i] = w;
        s2 += o.x * o.x + o.y * o.y + o.z * o.z + o.w * o.w;
    }
    for (int o = 32; o > 0; o >>= 1) s2 += __shfl_xor(s2, o);
    if (lane == 0) ((float*)(p.ws + WS_RS))[row] = rsqrtf(s2 * (1.f / D) + 1e-6f);
}

namespace att {
#define ALAS __attribute__((address_space(3)))
typedef short bf16x8 __attribute__((ext_vector_type(8)));
typedef short s16x4 __attribute__((ext_vector_type(4)));
typedef short v4i16_t __attribute__((ext_vector_type(4)));
typedef float f32x16 __attribute__((ext_vector_type(16)));
typedef unsigned u32x4_t __attribute__((ext_vector_type(4)));
typedef float f32x2_t __attribute__((ext_vector_type(2)));
typedef __bf16 bf16x2_t __attribute__((ext_vector_type(2)));
constexpr float LOG2E = 1.4426950408889634f;
constexpr float NEGB = -1e30f;
constexpr int DMAXT = 640, TABN = 712;

DI unsigned cvtpk(float lo, float hi) { f32x2_t v = {lo, hi}; bf16x2_t b = __builtin_convertvector(v, bf16x2_t); return __builtin_bit_cast(unsigned, b); }
DI s16x4 vtr(const ALAS char* p) { return __builtin_bit_cast(s16x4, __builtin_amdgcn_ds_read_tr16_b64_v4i16((ALAS v4i16_t*)p)); }
DI bf16x8 pack8(const f32x16& x, int s8) {
    u32x4_t w; w.x = cvtpk(x[s8 + 0], x[s8 + 1]); w.y = cvtpk(x[s8 + 2], x[s8 + 3]); w.z = cvtpk(x[s8 + 4], x[s8 + 5]); w.w = cvtpk(x[s8 + 6], x[s8 + 7]);
    return __builtin_bit_cast(bf16x8, w);
}
template <int DK> DI void k_offsets(int lane, unsigned (&ko)[DK / 16]) {
    const int r32 = lane & 31, hi = lane >> 5;
    const int x = (DK == 64) ? ((r32 >> 1) & 7) : ((r32 >> 2) & 3);
#pragma unroll
    for (int ks = 0; ks < DK / 16; ++ks) ko[ks] = (unsigned)(r32 * (DK * 2) + 16 * ((2 * ks + hi) ^ x));
}
DI void v_offsets(int lane, unsigned (&vo)[2]) {
    const int hi = lane >> 5, qp = (lane & 15) >> 2, sft = qp >> 1, d0 = 16 * ((lane >> 4) & 1) + 4 * (lane & 3);
#pragma unroll
    for (int db = 0; db < 2; ++db) vo[db] = (unsigned)((4 * hi + qp) * 128 + 64 * (db ^ sft) + 2 * d0);
}
DI unsigned k64_dst(int row, int ch) { return (unsigned)(row * 128 + 16 * (ch ^ ((row >> 1) & 7))); }
DI unsigned k96_dst(int row, int ch) { return (unsigned)(row * 192 + 16 * (ch ^ ((row >> 2) & 3))); }
DI unsigned v64_dst(int row, int ch) { return (unsigned)(row * 128 + 16 * (ch ^ (((row >> 1) & 1) << 2))); }

template <int DK, int MODE>
DI void tile_step(const ALAS char* kt, const ALAS char* vt, const unsigned (&ko)[DK / 16], const unsigned (&vo)[2], const bf16x8 (&qf)[DK / 16],
                  float c, float cb, const ALAS float* tb, float& m, float& l, f32x16 (&o)[2]) {
    f32x16 s0, s1;
#pragma unroll
    for (int r = 0; r < 16; ++r) { s0[r] = 0.f; s1[r] = 0.f; }
#pragma unroll
    for (int ks = 0; ks < DK / 16; ++ks) {
        const bf16x8 k0 = *(const ALAS bf16x8*)(kt + ko[ks]);
        const bf16x8 k1 = *(const ALAS bf16x8*)(kt + ko[ks] + 32 * DK * 2);
        s0 = __builtin_amdgcn_mfma_f32_32x32x16_bf16(k0, qf[ks], s0, 0, 0, 0);
        s1 = __builtin_amdgcn_mfma_f32_32x32x16_bf16(k1, qf[ks], s1, 0, 0, 0);
    }
    __builtin_amdgcn_sched_barrier(0);
    if (MODE == 0) {
#pragma unroll
        for (int r = 0; r < 16; ++r) { s0[r] = __builtin_fmaf(s0[r], c, cb); s1[r] = __builtin_fmaf(s1[r], c, cb); }
    } else {
#pragma unroll
        for (int r = 0; r < 16; ++r) { const int e = (r & 3) + 8 * (r >> 2); s0[r] = __builtin_fmaf(s0[r], c, tb[e]); s1[r] = __builtin_fmaf(s1[r], c, tb[32 + e]); }
    }
    float mt = __builtin_fmaxf(s0[0], s1[0]);
#pragma unroll
    for (int r = 1; r < 16; ++r) mt = __builtin_fmaxf(mt, __builtin_fmaxf(s0[r], s1[r]));
    mt = __builtin_fmaxf(mt, __shfl_xor(mt, 32));
    if (__any(mt > m)) {
        const float mn = __builtin_fmaxf(m, mt), a = __builtin_amdgcn_exp2f(m - mn);
        m = mn; l *= a;
#pragma unroll
        for (int r = 0; r < 16; ++r) { o[0][r] *= a; o[1][r] *= a; }
    }
    float rs = 0.f;
#pragma unroll
    for (int r = 0; r < 16; ++r) { s0[r] = __builtin_amdgcn_exp2f(s0[r] - m); s1[r] = __builtin_amdgcn_exp2f(s1[r] - m); rs += s0[r] + s1[r]; }
    l += rs;
    bf16x8 pf[4];
    pf[0] = pack8(s0, 0); pf[1] = pack8(s0, 8); pf[2] = pack8(s1, 0); pf[3] = pack8(s1, 8);
    __builtin_amdgcn_sched_barrier(0);
#pragma unroll
    for (int db = 0; db < 2; ++db)
#pragma unroll
        for (int kk = 0; kk < 4; ++kk) {
            const s16x4 lo = vtr(vt + vo[db] + kk * 2048), hh = vtr(vt + vo[db] + kk * 2048 + 1024);
            const bf16x8 vf = (bf16x8){lo[0], lo[1], lo[2], lo[3], hh[0], hh[1], hh[2], hh[3]};
            o[db] = __builtin_amdgcn_mfma_f32_32x32x16_bf16(vf, pf[kk], o[db], 0, 0, 0);
        }
    __builtin_amdgcn_sched_barrier(0);
}

constexpr int L_K0 = 0, L_K1 = 12288, L_V0 = 24576, L_V1 = 32768, L_TAB = 40960;

DI void build_table(ALAS float* A, const float* bt, int W, int tid, int nthreads) {
    for (int i = tid; i < TABN; i += nthreads) { const int d = DMAXT - i; float v = NEGB; if (d >= 0 && d < W) v = bt ? LOG2E * bt[d < 512 ? d : 512] : 0.f; A[i] = v; }
}

DI void store_mixed(const Params& p, const f32x16 (&acc)[2], size_t tok, int mcol, int hi);
DI void mla_unit(const Params& p, int tid, ALAS char* lds, int b, int h, int qt) {
    const int lane = tid & 63, w = __builtin_amdgcn_readfirstlane(tid >> 6), r32 = lane & 31, hi = lane >> 5;
    const int tq = 256 * qt + 32 * w + r32;
    const bf16_t* Qm = (const bf16_t*)(p.ws + WS_QM); const bf16_t* Km = (const bf16_t*)(p.ws + WS_KM); const bf16_t* Vm = (const bf16_t*)(p.ws + WS_VM);
    bf16x8 qf[6];
    { const bf16_t* qrow = Qm + ((size_t)b * T + tq) * 384 + h * 96;
#pragma unroll
      for (int ks = 0; ks < 6; ++ks) qf[ks] = *(const bf16x8*)(qrow + 16 * ks + 8 * hi); }
    unsigned ko[6], vo[2]; k_offsets<96>(lane, ko); v_offsets(lane, vo);
    f32x16 o[2];
#pragma unroll
    for (int r = 0; r < 16; ++r) { o[0][r] = 0.f; o[1][r] = 0.f; }
    float m = NEGB, l = 0.f;
    const float c = 0.10206207261596577f * LOG2E;
    const int ntiles = 4 * qt + 4, mylast = 4 * qt + (w >> 1);
    const ALAS float* tabA = (const ALAS float*)(lds + L_TAB);
    const int kr0 = tid / 12, kc0 = tid % 12, kr1 = (tid + 512) / 12, kc1 = (tid + 512) % 12, vr = tid >> 3, vc = tid & 7;
    const bf16_t* ksrc0 = Km + ((size_t)b * T + kr0) * 384 + h * 96 + kc0 * 8;
    const bf16_t* ksrc1 = Km + ((size_t)b * T + kr1) * 384 + h * 96 + kc1 * 8;
    const bf16_t* vsrc = Vm + ((size_t)b * T + vr) * 256 + h * 64 + vc * 8;
    const unsigned kd0 = k96_dst(kr0, kc0), kd1 = k96_dst(kr1, kc1), vd = v64_dst(vr, vc);
    u32x4_t ka, kb = (u32x4_t){0u, 0u, 0u, 0u}, va;
    ka = *(const u32x4_t*)ksrc0; if (tid < 256) kb = *(const u32x4_t*)ksrc1; va = *(const u32x4_t*)vsrc;
    *(ALAS u32x4_t*)(lds + L_K0 + kd0) = ka; if (tid < 256) *(ALAS u32x4_t*)(lds + L_K0 + kd1) = kb; *(ALAS u32x4_t*)(lds + L_V0 + vd) = va;
    __syncthreads();
    for (int jt = 0; jt < ntiles; ++jt) {
        const int cur = jt & 1;
        if (jt + 1 < ntiles) { const size_t adv = (size_t)(jt + 1) * 64;
            ka = *(const u32x4_t*)(ksrc0 + adv * 384); if (tid < 256) kb = *(const u32x4_t*)(ksrc1 + adv * 384); va = *(const u32x4_t*)(vsrc + adv * 256); }
        if (jt <= mylast) {
            const ALAS char* kt = lds + (cur ? L_K1 : L_K0); const ALAS char* vt = lds + (cur ? L_V1 : L_V0);
            if (jt == mylast) { const int D0 = tq - 64 * jt - 4 * hi; tile_step<96, 1>(kt, vt, ko, vo, qf, c, 0.f, tabA + (DMAXT - D0), m, l, o); }
            else tile_step<96, 0>(kt, vt, ko, vo, qf, c, 0.f, tabA, m, l, o);
        }
        if (jt + 1 < ntiles) { ALAS char* kn = lds + (cur ? L_K0 : L_K1); ALAS char* vn = lds + (cur ? L_V0 : L_V1);
            *(ALAS u32x4_t*)(kn + kd0) = ka; if (tid < 256) *(ALAS u32x4_t*)(kn + kd1) = kb; *(ALAS u32x4_t*)(vn + vd) = va; }
        __syncthreads();
    }
    l += __shfl_xor(l, 32);
    { const float invl = 1.f / l;
#pragma unroll
      for (int r = 0; r < 16; ++r) { o[0][r] *= invl; o[1][r] *= invl; } }
    store_mixed(p, o, (size_t)b * T + tq, 256 + 64 * h, hi);
}
DI void acc_scaled(f32x16 (&acc)[2], const f32x16 (&o)[2], float f) {
#pragma unroll
    for (int r = 0; r < 16; ++r) { acc[0][r] += f * o[0][r]; acc[1][r] += f * o[1][r]; }
}
DI void store_mixed(const Params& p, const f32x16 (&acc)[2], size_t tok, int mcol, int hi) {
    const bf16_t* zp = (const bf16_t*)(p.ws + WS_P) + tok * NP + C_Z + mcol;
    bf16_t* mp = (bf16_t*)(p.ws + WS_MIX) + tok * 1024 + mcol;
    float one = 1.f; asm volatile("" : "+v"(one));
#pragma unroll
    for (int db = 0; db < 2; ++db)
#pragma unroll
        for (int g = 0; g < 4; ++g) {
            const int d = 32 * db + 8 * g + 4 * hi;
            const uint2 zw = *(const uint2*)(zp + d);
            const float z0 = bflo(zw.x), z1 = bfhi(zw.x), z2 = bflo(zw.y), z3 = bfhi(zw.y);
            const float v0 = acc[db][4 * g + 0] * z0 / (one + __expf(-z0)), v1 = acc[db][4 * g + 1] * z1 / (one + __expf(-z1));
            const float v2 = acc[db][4 * g + 2] * z2 / (one + __expf(-z2)), v3 = acc[db][4 * g + 3] * z3 / (one + __expf(-z3));
            uint2 ow; ow.x = cvtpk(v0, v1); ow.y = cvtpk(v2, v3);
            *(uint2*)(mp + d) = ow;
        }
}
DI void zero2(f32x16 (&o)[2]) {
#pragma unroll
    for (int r = 0; r < 16; ++r) { o[0][r] = 0.f; o[1][r] = 0.f; }
}
struct Stage64 {
    const bf16_t* ks; const bf16_t* vs; unsigned kd, vd; u32x4_t ka, va;
    DI void init(const bf16_t* kbase, const bf16_t* vbase, size_t pitch, int tid) { const int row = tid >> 3, ch = tid & 7; ks = kbase + row * pitch + ch * 8; vs = vbase + row * pitch + ch * 8; kd = k64_dst(row, ch); vd = v64_dst(row, ch); }
    DI void load(size_t rowoff_elems) { ka = *(const u32x4_t*)(ks + rowoff_elems); va = *(const u32x4_t*)(vs + rowoff_elems); }
    DI void store(ALAS char* kb, ALAS char* vb) const { *(ALAS u32x4_t*)(kb + kd) = ka; *(ALAS u32x4_t*)(vb + vd) = va; }
};

DI void swa_unit(const Params& p, int tid, ALAS char* lds, int layer, int b, int qt) {
    const int lane = tid & 63, w = __builtin_amdgcn_readfirstlane(tid >> 6), r32 = lane & 31, hi = lane >> 5;
    const int tq = 32 * qt + r32; const size_t tok = (size_t)b * T + tq;
    const bf16_t* P = (const bf16_t*)(p.ws + WS_P);
    bf16x8 qf[4];
#pragma unroll
    for (int ks = 0; ks < 4; ++ks) qf[ks] = *(const bf16x8*)(P + tok * NP + C_CQ + 64 * w + 16 * ks + 8 * hi);
    unsigned ko[4], vo[2]; k_offsets<64>(lane, ko); v_offsets(lane, vo);
    f32x16 o[2]; zero2(o);
    float m = NEGB, l = 0.f;
    const float c = 0.125f * LOG2E;
    const int jd = qt >> 1, ntl = jd + 1 < 3 ? jd + 1 : 3;
    const ALAS float* tab = (const ALAS float*)(lds + L_TAB) + w * TABN;
    Stage64 st; st.init(P + (size_t)b * T * NP + C_CK, P + (size_t)b * T * NP + C_CV, NP, tid);
    st.load((size_t)(64 * jd) * NP); st.store(lds + L_K0, lds + L_V0);
    __syncthreads();
    for (int i = 0; i < ntl; ++i) {
        const int cur = i & 1, jt = jd - i;
        if (i + 1 < ntl) st.load((size_t)(64 * (jt - 1)) * NP);
        { const int D0 = tq - 64 * jt - 4 * hi;
          tile_step<64, 1>(lds + (cur ? L_K1 : L_K0), lds + (cur ? L_V1 : L_V0), ko, vo, qf, c, 0.f, tab + (DMAXT - D0), m, l, o); }
        if (i + 1 < ntl) st.store(lds + (cur ? L_K0 : L_K1), lds + (cur ? L_V0 : L_V1));
        __syncthreads();
    }
    l += __shfl_xor(l, 32);
    l += __builtin_amdgcn_exp2f(p.sinks[layer * 8 + w] * LOG2E - m);
    f32x16 acc[2]; zero2(acc); acc_scaled(acc, o, 1.f / l);
    store_mixed(p, acc, tok, 512 + 64 * w, hi);
}

template <bool FIRST> DI void oa_accum(float* oap, const f32x16 (&o)[2], float f, int hi) {
#pragma unroll
    for (int db = 0; db < 2; ++db)
#pragma unroll
        for (int g = 0; g < 4; ++g) {
            float4* q = (float4*)(oap + 32 * db + 8 * g + 4 * hi);
            float4 v = FIRST ? make_float4(0.f, 0.f, 0.f, 0.f) : *q;
            v.x += f * o[db][4 * g + 0]; v.y += f * o[db][4 * g + 1]; v.z += f * o[db][4 * g + 2]; v.w += f * o[db][4 * g + 3];
            *q = v;
        }
}
constexpr int L_TSEL = L_TAB, L_TWIN = L_TAB + 4 * TABN * 4, L_TCMP = L_TWIN + 4 * TABN * 4, CMPN = 520, L_IMP = 73728, L_SELM = L_IMP + 65536, L_UNION = L_SELM + 512;
DI void nsa_tables(const Params& p, int tid, ALAS char* lds) {
    const float* bt = (const float*)(p.ws + WS_BTAB);
    for (int h = 0; h < 4; ++h) {
        build_table((ALAS float*)(lds + L_TSEL) + h * TABN, bt + h * BT_STRIDE, 1 << 30, tid, 512);
        build_table((ALAS float*)(lds + L_TWIN) + h * TABN, bt + h * BT_STRIDE, 512, tid, 512);
        for (int i = tid; i < CMPN; i += 512) ((ALAS float*)(lds + L_TCMP))[h * CMPN + i] = i == 0 ? NEGB : LOG2E * bt[h * BT_STRIDE + (i - 1 < 512 ? i - 1 : 512)];
    }
}
DI void cmp_scores(const ALAS char* kt, const unsigned (&ko)[4], const bf16x8 (&qf)[4], float c, bool far, float cb31, const ALAS float* G, int D0c, f32x16& s0, f32x16& s1) {
#pragma unroll
    for (int r = 0; r < 16; ++r) { s0[r] = 0.f; s1[r] = 0.f; }
#pragma unroll
    for (int ks = 0; ks < 4; ++ks) {
        const bf16x8 k0 = *(const ALAS bf16x8*)(kt + ko[ks]);
        const bf16x8 k1 = *(const ALAS bf16x8*)(kt + ko[ks] + 32 * 128);
        s0 = __builtin_amdgcn_mfma_f32_32x32x16_bf16(k0, qf[ks], s0, 0, 0, 0);
        s1 = __builtin_amdgcn_mfma_f32_32x32x16_bf16(k1, qf[ks], s1, 0, 0, 0);
    }
    __builtin_amdgcn_sched_barrier(0);
    if (far) {
#pragma unroll
        for (int r = 0; r < 16; ++r) { s0[r] = __builtin_fmaf(s0[r], c, cb31); s1[r] = __builtin_fmaf(s1[r], c, cb31); }
    } else {
#pragma unroll
        for (int r = 0; r < 16; ++r) {
            const int e = (r & 3) + 8 * (r >> 2);
            int d0 = D0c - 16 * e, d1 = D0c - 16 * (e + 32);
            d0 = d0 < -1 ? -1 : (d0 > 512 ? 512 : d0); d1 = d1 < -1 ? -1 : (d1 > 512 ? 512 : d1);
            s0[r] = __builtin_fmaf(s0[r], c, G[d0 + 1]); s1[r] = __builtin_fmaf(s1[r], c, G[d1 + 1]);
        }
    }
}
DI void nsa_unit(const Params& p, int tid, ALAS char* lds, int b, int qt) {
    const int lane = tid & 63, w = __builtin_amdgcn_readfirstlane(tid >> 6), r32 = lane & 31, hi = lane >> 5;
    const int h = w & 3, th = w >> 2;
    const int tq = 64 * qt + 32 * th + r32; const size_t tok = (size_t)b * T + tq;
    const bf16_t* P = (const bf16_t*)(p.ws + WS_P);
    bf16x8 qf[4];
#pragma unroll
    for (int ks = 0; ks < 4; ++ks) qf[ks] = *(const bf16x8*)(P + tok * NP + C_AQ + 64 * h + 16 * ks + 8 * hi);
    unsigned ko[4], vo[2]; k_offsets<64>(lane, ko); v_offsets(lane, vo);
    const float c = 0.125f * LOG2E;
    const float* bt = (const float*)(p.ws + WS_BTAB) + h * BT_STRIDE;
    const float b31 = LOG2E * bt[512];
    float g0, g1, g2;
    { float one = 1.f; asm volatile("" : "+v"(one));
      const bf16_t* gp = P + tok * NP + C_AG + 3 * h; g0 = one / (one + __expf(-bf2f(gp[0]))); g1 = one / (one + __expf(-bf2f(gp[1]))); g2 = one / (one + __expf(-bf2f(gp[2]))); }
    float* oap = (float*)(p.ws + WS_OA) + tok * 256 + 64 * h;
    Stage64 st;
    const int nvmax = 4 * qt + 3 < 255 ? 4 * qt + 3 : 255, nct = (nvmax + 63) >> 6;
    const ALAS float* G = (const ALAS float*)(lds + L_TCMP) + h * CMPN;
    ALAS float* impw = (ALAS float*)(lds + L_IMP) + (h * 64 + 32 * th + r32) * 64;
    const int tqmin = 64 * qt + 32 * th;
    { float zf = 0.f; asm volatile("" : "+v"(zf));
#pragma unroll
      for (int i = 0; i < 32; ++i) impw[32 * hi + i] = zf; }
    st.init((const bf16_t*)(p.ws + WS_KC) + (size_t)b * 256 * 64, (const bf16_t*)(p.ws + WS_VC) + (size_t)b * 256 * 64, 64, tid);
    float m = NEGB, l = 0.f;
    for (int pass = 0; pass < 2; ++pass) {
        f32x16 o[2]; zero2(o);
        const float invl = (pass == 1 && tq >= 31) ? 1.f / l : 0.f;
        float carry = 0.f;
        __syncthreads();
        st.load(0); st.store(lds + L_K0, lds + L_V0);
        __syncthreads();
        for (int ct = 0; ct < nct; ++ct) {
            const int cur = ct & 1;
            if (ct + 1 < nct) st.load((size_t)(64 * (ct + 1)) * 64);
            const ALAS char* kt = lds + (cur ? L_K1 : L_K0); const ALAS char* vt = lds + (cur ? L_V1 : L_V0);
            const bool far = tqmin - (16 * (64 * ct + 63) + 31) >= 413;
            const int D0c = tq - 31 - 16 * (64 * ct) - 64 * hi;
            f32x16 s0, s1;
            cmp_scores(kt, ko, qf, c, far, b31, G, D0c, s0, s1);
            __builtin_amdgcn_sched_barrier(0);
            if (pass == 0) {
                float mt = __builtin_fmaxf(s0[0], s1[0]);
#pragma unroll
                for (int r = 1; r < 16; ++r) mt = __builtin_fmaxf(mt, __builtin_fmaxf(s0[r], s1[r]));
                mt = __builtin_fmaxf(mt, __shfl_xor(mt, 32));
                const float mn = __builtin_fmaxf(m, mt); l *= __builtin_amdgcn_exp2f(m - mn); m = mn;
                float rs = 0.f;
#pragma unroll
                for (int r = 0; r < 16; ++r) rs += __builtin_amdgcn_exp2f(s0[r] - m) + __builtin_amdgcn_exp2f(s1[r] - m);
                l += rs;
            } else {
#pragma unroll
                for (int r = 0; r < 16; ++r) { s0[r] = __builtin_amdgcn_exp2f(s0[r] - m) * invl; s1[r] = __builtin_amdgcn_exp2f(s1[r] - m) * invl; }
                bf16x8 pf[4];
                pf[0] = pack8(s0, 0); pf[1] = pack8(s0, 8); pf[2] = pack8(s1, 0); pf[3] = pack8(s1, 8);
                __builtin_amdgcn_sched_barrier(0);
                f32x16 im;
#pragma unroll
                for (int r = 0; r < 16; ++r) im[r] = 0.f;
#pragma unroll
                for (int kk = 0; kk < 4; ++kk) {
                    bf16x8 of;
#pragma unroll
                    for (int j = 0; j < 8; ++j) { const int cl = 16 * kk + 8 * (j >> 2) + 4 * hi + (j & 3); const int sb = cl >> 2; const bool last = (cl & 3) == 3;
                        of[j] = (short)(sb == r32 ? (last ? 0x3F80 : 0x4000) : ((last && sb + 1 == r32) ? 0x3F80 : 0)); }
                    im = __builtin_amdgcn_mfma_f32_32x32x16_bf16(of, pf[kk], im, 0, 0, 0);
#pragma unroll
                    for (int db = 0; db < 2; ++db) {
                        const s16x4 lo = vtr(vt + vo[db] + kk * 2048), hh = vtr(vt + vo[db] + kk * 2048 + 1024);
                        const bf16x8 vf = (bf16x8){lo[0], lo[1], lo[2], lo[3], hh[0], hh[1], hh[2], hh[3]};
                        o[db] = __builtin_amdgcn_mfma_f32_32x32x16_bf16(vf, pf[kk], o[db], 0, 0, 0);
                    }
                }
                __builtin_amdgcn_sched_barrier(0);
                if (hi == 0) {
                    im[0] += carry; carry = im[8];
#pragma unroll
                    for (int r = 0; r < 8; ++r) impw[16 * ct + (r & 3) + 8 * (r >> 2)] = im[r];
                    if (ct == nct - 1 && 16 * ct + 16 < 64) impw[16 * ct + 16] = im[8];
                } else {
#pragma unroll
                    for (int r = 0; r < 8; ++r) impw[16 * ct + 4 + (r & 3) + 8 * (r >> 2)] = im[r];
                }
            }
            if (ct + 1 < nct) st.store(lds + (cur ? L_K0 : L_K1), lds + (cur ? L_V0 : L_V1));
            __syncthreads();
        }
        if (pass == 0) l += __shfl_xor(l, 32);
        else oa_accum<true>(oap, o, g0, hi);
    }
    {
        const int tl = tid >> 3, sub = tid & 7, cur = qt;
        unsigned long long mask;
        if (cur + 1 <= 16) mask = (2ull << cur) - 1ull;
        else {
            float v[8];
            const ALAS float* ib = (const ALAS float*)(lds + L_IMP) + tl * 64 + sub * 8;
#pragma unroll
            for (int i = 0; i < 8; ++i) { const int s = sub * 8 + i; const float x = (ib[i] + ib[4096 + i]) + (ib[8192 + i] + ib[12288 + i]); v[i] = (s >= 1 && s <= cur - 2) ? x : -3e38f; }
            mask = 1ull | (1ull << cur) | (1ull << (cur - 1));
            for (int it = 0; it < 13; ++it) {
                float best = v[0]; int bi = 0;
#pragma unroll
                for (int i = 1; i < 8; ++i) if (v[i] > best) { best = v[i]; bi = i; }
                int bs = sub * 8 + bi;
#pragma unroll
                for (int off = 1; off < 8; off <<= 1) { const float ob = __shfl_xor(best, off); const int os = __shfl_xor(bs, off); if (ob > best || (ob == best && os < bs)) { best = ob; bs = os; } }
                if (best > -1e38f) { mask |= 1ull << bs;
#pragma unroll
                    for (int i = 0; i < 8; ++i) if (sub * 8 + i == bs) v[i] = -3e38f; }
            }
        }
        if (sub == 0) ((ALAS unsigned long long*)(lds + L_SELM))[tl] = mask;
        __syncthreads();
    }
    unsigned long long mymask = ((const ALAS unsigned long long*)(lds + L_SELM))[32 * th + r32];
    unsigned long long uni = 0ull;
    { const ALAS unsigned long long* sm = (const ALAS unsigned long long*)(lds + L_SELM);
      for (int i = 0; i < 64; ++i) uni |= sm[i]; }
    uni = ((unsigned long long)(unsigned)__builtin_amdgcn_readfirstlane((int)(uni >> 32)) << 32) | (unsigned)__builtin_amdgcn_readfirstlane((int)uni);
    {
        f32x16 o[2]; zero2(o); m = NEGB; l = 0.f;
        const ALAS float* tab = (const ALAS float*)(lds + L_TSEL) + h * TABN;
        st.init(P + (size_t)b * T * NP + C_KSLC, P + (size_t)b * T * NP + C_VSLC, NP, tid);
        unsigned long long rem = uni;
        int s = 63 - __builtin_clzll(rem); rem &= ~(1ull << s);
        st.load((size_t)(64 * s) * NP); st.store(lds + L_K0, lds + L_V0);
        __syncthreads();
        int cur = 0;
        for (;;) {
            const int sn = rem ? 63 - __builtin_clzll(rem) : -1;
            if (sn >= 0) { rem &= ~(1ull << sn); st.load((size_t)(64 * sn) * NP); }
            const bool mine = (mymask >> s) & 1ull;
            if (__any(mine)) {
                const ALAS char* kt = lds + (cur ? L_K1 : L_K0); const ALAS char* vt = lds + (cur ? L_V1 : L_V0);
                const int D0 = tq - 64 * s - 4 * hi;
                if (qt - s <= 7) tile_step<64, 1>(kt, vt, ko, vo, qf, c, 0.f, tab + (mine ? DMAXT - D0 : DMAXT + 1), m, l, o);
                else tile_step<64, 0>(kt, vt, ko, vo, qf, c, mine ? b31 : NEGB, tab, m, l, o);
            }
            if (sn >= 0) st.store(lds + (cur ? L_K0 : L_K1), lds + (cur ? L_V0 : L_V1));
            __syncthreads();
            if (sn < 0) break;
            s = sn; cur ^= 1;
        }
        l += __shfl_xor(l, 32);
        oa_accum<false>(oap, o, g1 / l, hi);
    }
    {
        f32x16 o[2]; zero2(o); m = NEGB; l = 0.f;
        const ALAS float* tab = (const ALAS float*)(lds + L_TWIN) + h * TABN;
        st.init(P + (size_t)b * T * NP + C_KWIN, P + (size_t)b * T * NP + C_VWIN, NP, tid);
        const int ntl = qt + 1 < 9 ? qt + 1 : 9;
        st.load((size_t)(64 * qt) * NP); st.store(lds + L_K0, lds + L_V0);
        __syncthreads();
        for (int i = 0; i < ntl; ++i) {
            const int cur = i & 1, jt = qt - i;
            if (i + 1 < ntl) st.load((size_t)(64 * (jt - 1)) * NP);
            { const int D0 = tq - 64 * jt - 4 * hi;
              tile_step<64, 1>(lds + (cur ? L_K1 : L_K0), lds + (cur ? L_V1 : L_V0), ko, vo, qf, c, 0.f, tab + (DMAXT - D0), m, l, o); }
            if (i + 1 < ntl) st.store(lds + (cur ? L_K0 : L_K1), lds + (cur ? L_V0 : L_V1));
            __syncthreads();
        }
        l += __shfl_xor(l, 32);
        oa_accum<false>(oap, o, g2 / l, hi);
    }
    { f32x16 acc[2];
#pragma unroll
      for (int db = 0; db < 2; ++db)
#pragma unroll
        for (int g = 0; g < 4; ++g) { const float4 v = *(const float4*)(oap + 32 * db + 8 * g + 4 * hi); acc[db][4 * g] = v.x; acc[db][4 * g + 1] = v.y; acc[db][4 * g + 2] = v.z; acc[db][4 * g + 3] = v.w; }
      store_mixed(p, acc, tok, 64 * h, hi); }
}
constexpr int L_CRED = 0, L_CHID = 16384, CHID_PITCH = 272;
DI void compress_unit(const Params& p, int tid, ALAS char* lds, int layer, int b, int which, int ct) {
    const int lane = tid & 63, w = __builtin_amdgcn_readfirstlane(tid >> 6), r32 = lane & 31, hi = lane >> 5, nb = w & 3, kh = w >> 2;
    const int lw = layer * 2 + which;
    const bf16_t* Prow = (const bf16_t*)(p.ws + WS_P) + ((size_t)b * T + 16 * (32 * ct + r32)) * NP + (which ? C_VCMP : C_KCMP) + 8 * hi;
    const bf16_t* W1 = (const bf16_t*)(p.ws + WS_W1T) + ((size_t)lw * 128 + 32 * nb + r32) * 2048 + 8 * hi;
    f32x16 acc;
#pragma unroll
    for (int r = 0; r < 16; ++r) acc[r] = 0.f;
#pragma unroll 8
    for (int ks = 0; ks < 64; ++ks) { const int kk = kh * 64 + ks;
        const bf16x8 a = *(const bf16x8*)(Prow + (size_t)(kk >> 2) * NP + (kk & 3) * 16);
        const bf16x8 bb = *(const bf16x8*)(W1 + 16 * kk);
        acc = __builtin_amdgcn_mfma_f32_32x32x16_bf16(a, bb, acc, 0, 0, 0); }
    ALAS float* red = (ALAS float*)(lds + L_CRED) + nb * 1024;
    if (kh == 1) {
#pragma unroll
        for (int r = 0; r < 16; ++r) red[((r & 3) + 8 * (r >> 2) + 4 * hi) * 32 + r32] = acc[r];
    }
    __syncthreads();
    if (kh == 0) {
        const float bv = ((const float*)(p.ws + WS_BVEC))[lw * 128 + 32 * nb + r32];
#pragma unroll
        for (int r = 0; r < 16; ++r) { const int c = (r & 3) + 8 * (r >> 2) + 4 * hi; const float a = acc[r] + red[c * 32 + r32] + bv;
            *(ALAS bf16_t*)(lds + L_CHID + c * CHID_PITCH + (32 * nb + r32) * 2) = f2bf(a / (1.f + __expf(-a))); }
    }
    __syncthreads();
    if (w < 2) {
        const bf16_t* W2 = (const bf16_t*)(p.ws + WS_W2T) + ((size_t)lw * 64 + 32 * w + r32) * 128 + 8 * hi;
        f32x16 o;
#pragma unroll
        for (int r = 0; r < 16; ++r) o[r] = 0.f;
#pragma unroll
        for (int ks = 0; ks < 8; ++ks) {
            const bf16x8 a = *(const bf16x8*)(W2 + 16 * ks);
            const bf16x8 hb = *(const ALAS bf16x8*)(lds + L_CHID + r32 * CHID_PITCH + (16 * ks + 8 * hi) * 2);
            o = __builtin_amdgcn_mfma_f32_32x32x16_bf16(a, hb, o, 0, 0, 0); }
        const int c = 32 * ct + r32;
        bf16_t* outp = (bf16_t*)(p.ws + (which ? WS_VC : WS_KC)) + ((size_t)b * 256 + c) * 64 + 32 * w + 4 * hi;
#pragma unroll
        for (int g = 0; g < 4; ++g) { uint2 ow; ow.x = cvtpk(o[4 * g], o[4 * g + 1]); ow.y = cvtpk(o[4 * g + 2], o[4 * g + 3]); if (c == 255) { ow.x = 0u; ow.y = 0u; } *(uint2*)(outp + 8 * g) = ow; }
    }
    __syncthreads();
}
DI void krope_items(const Params& p, int start, int stride) {
    const bf16_t* P = (const bf16_t*)(p.ws + WS_P); bf16_t* Km = (bf16_t*)(p.ws + WS_KM); const float2* rope = (const float2*)(p.ws + WS_ROPE);
    for (int it = start; it < NTOK * 16; it += stride) { const int tok = it >> 4, i = it & 15;
        const float x1 = bf2f(P[(size_t)tok * NP + C_BKR + i]), x2 = bf2f(P[(size_t)tok * NP + C_BKR + 16 + i]); const float2 c2 = rope[(size_t)(tok & (T - 1)) * 16 + i];
        const bf16_t o1 = f2bf(x1 * c2.x - x2 * c2.y), o2 = f2bf(x2 * c2.x + x1 * c2.y);
#pragma unroll
        for (int hh = 0; hh < 4; ++hh) { Km[(size_t)tok * 384 + hh * 96 + 64 + i] = o1; Km[(size_t)tok * 384 + hh * 96 + 80 + i] = o2; } }
}
}

constexpr int SMEM_BYTES = 160 * 1024;
constexpr int PARAM_OFF = SMEM_BYTES - 256;
constexpr int VSMEM = 49152;

__global__ void __launch_bounds__(512, 2) mega(Params p0) {
    extern __shared__ __attribute__((aligned(16))) char smem[];
    cg::grid_group grid = cg::this_grid();
    if (threadIdx.x == 0) {
        ALAS unsigned long long* pl = (ALAS unsigned long long*)((ALAS char*)smem + PARAM_OFF);
#pragma unroll
        for (int i_ = 0; i_ < 14; ++i_) pl[i_] = (unsigned long long)p0.in[i_];
        pl[14] = (unsigned long long)p0.xout; pl[15] = (unsigned long long)p0.ws;
    }
    __syncthreads();
    const int wid_s = __builtin_amdgcn_readfirstlane((int)(threadIdx.x >> 6));
#ifndef PROBE_REP_K
#define PROBE_REP_K -2
#endif
#ifndef PROBE_SYNC
#define PROBE_SYNC 0
#endif
    constexpr int NSTEP = 5 + (PROBE_REP_K >= 0 ? 1 : 0);
    for (int ph = 0; ph < 1 + NSTEP * DEPTH; ++ph) {
        int ph_ = ph; asm volatile("" : "+s"(ph_));
#define MKTID(dst) do { int w__ = wid_s; unsigned ones__ = ~0u; asm volatile("" : "+s"(w__), "+s"(ones__)); \
        (dst) = w__ * 64 + (int)__builtin_amdgcn_mbcnt_hi(ones__, __builtin_amdgcn_mbcnt_lo(ones__, 0u)); } while (0)
        Params p;
        {
            unsigned poff_ = PARAM_OFF; asm volatile("" : "+v"(poff_));
            const ALAS unsigned* pl = (const ALAS unsigned*)((ALAS char*)smem + poff_);
#pragma unroll
            for (int i_ = 0; i_ < 16; ++i_) {
                const unsigned lo_ = (unsigned)__builtin_amdgcn_readfirstlane((int)pl[2 * i_]), hi_ = (unsigned)__builtin_amdgcn_readfirstlane((int)pl[2 * i_ + 1]);
                const unsigned long long v_ = ((unsigned long long)hi_ << 32) | lo_;
                if (i_ < 14) p.in[i_] = (const float*)v_; else if (i_ == 14) p.xout = (float*)v_; else p.ws = (char*)v_;
            }
        }
        int G = gridDim.x, bid = blockIdx.x; asm volatile("" : "+s"(G), "+s"(bid));
        const int NGW = G * 8;
        const int l = (ph_ - 1) / NSTEP, j_ = (ph_ - 1) % NSTEP, k = ph_ == 0 ? -1 : ((PROBE_REP_K >= 0 && j_ > PROBE_REP_K) ? j_ - 1 : j_);
        if (k == -1) {
            int t_; MKTID(t_);
            pro_all(p, bid * 512 + t_, G * 512);
            pro_weights(p, bid, G, t_, smem);
            for (int row = bid * 8 + (t_ >> 6); row < NTOK; row += NGW) pro_xrow(p, row, t_ & 63);
        } else if (k == 0) {
            int t_; MKTID(t_);
            pg8::Gemm g{((bf16_t*)(p.ws + WS_XB)), ((bf16_t*)(p.ws + WS_WTIN)) + (size_t)l * NP * D, NTOK, NP, D, D};
            pg8::StaticOrder S; S.init(NTOK, NP, G, bid);
            pg8::EpiInProj E{((bf16_t*)(p.ws + WS_P)), ((float*)(p.ws + WS_RS)), ((float*)(p.ws + WS_SSQQ)), ((float*)(p.ws + WS_SSQKV))};
            pg8::gemm_phase<pg8::EpiInProj, pg8::StaticOrder, true, true>(t_, (PG8_LAS unsigned char*)smem, g, S, E);
        } else if (k == 1) {
            int t_; MKTID(t_);
            const int G2 = G >> 1;
            if (bid < G2) {
                pg8::Gemm g{(const bf16_t*)(p.ws + WS_P) + C_BCQ, (const bf16_t*)(p.ws + WS_WUQ) + (size_t)l * 512 * 256, NTOK, 512, 256, NP};
                pg8::StaticOrder S; S.init(NTOK, 512, G2, bid);
                pg8::EpiQ E{(bf16_t*)(p.ws + WS_QM), (const float*)(p.ws + WS_SSQQ), (const float2*)(p.ws + WS_ROPE)};
                pg8::gemm_phase<pg8::EpiQ, pg8::StaticOrder, true, true>(t_, (PG8_LAS unsigned char*)smem, g, S, E);
            } else {
                { pg8::Gemm g{(const bf16_t*)(p.ws + WS_P) + C_BCKV, (const bf16_t*)(p.ws + WS_WUKV) + (size_t)l * 512 * 128, NTOK, 512, 128, NP};
                  pg8::StaticOrder S; S.init(NTOK, 512, G - G2, bid - G2);
                  pg8::EpiKV E{(bf16_t*)(p.ws + WS_KM), (bf16_t*)(p.ws + WS_VM), (const float*)(p.ws + WS_SSQKV)};
                  pg8::gemm_phase<pg8::EpiKV, pg8::StaticOrder, true, true>(t_, (PG8_LAS unsigned char*)smem, g, S, E); }
                __syncthreads();
                for (int u = bid - G2; u < 64; u += G - G2) { int tt; MKTID(tt); att::compress_unit(p, tt, (ALAS char*)smem, l, u >> 4, (u >> 3) & 1, u & 7); }
                { int tk; MKTID(tk); att::krope_items(p, (bid - G2) * 512 + tk, (G - G2) * 512); }
            }
        } else if (k == 2) {
            ALAS char* L = (ALAS char*)smem;
            { int tb; MKTID(tb); att::build_table((ALAS float*)(L + att::L_TAB), nullptr, 1 << 30, tb, 512); }
            __syncthreads();
            for (int u = bid; u < 256; u += G) { const int qt = 15 - (u >> 4), bh = u & 15; int tt; MKTID(tt); att::mla_unit(p, tt, L, bh >> 2, bh & 3, qt); }
            __syncthreads();
            { int tb; MKTID(tb); att::nsa_tables(p, tb, L); }
            __syncthreads();
            for (int u = bid; u < 256; u += G) { int tt; MKTID(tt); att::nsa_unit(p, tt, L, u & 3, u >> 2); }
            __syncthreads();
            { int tb; MKTID(tb); for (int hh = 0; hh < 8; ++hh) att::build_table((ALAS float*)(L + att::L_TAB) + hh * att::TABN, (const float*)(p.ws + WS_BTAB) + (4 + hh) * BT_STRIDE, 128, tb, 512); }
            __syncthreads();
            for (int u = bid; u < 512; u += G) { int tt; MKTID(tt); att::swa_unit(p, tt, L, l, u & 3, u >> 2); }
        } else if (k == 3) {
            int t_; MKTID(t_);
            pg8::Gemm g{((bf16_t*)(p.ws + WS_MIX)), ((bf16_t*)(p.ws + WS_WTOUT)) + (size_t)l * D * D, NTOK, D, D, D};
            pg8::StaticOrder S; S.init(NTOK, D, G, bid);
            pg8::EpiF32 E{((float*)(p.ws + WS_P)), D};
            pg8::gemm_phase<pg8::EpiF32, pg8::StaticOrder, true, true>(t_, (PG8_LAS unsigned char*)smem, g, S, E);
        } else {
            int t_; MKTID(t_);
            for (int row = bid * 8 + (t_ >> 6); row < NTOK; row += NGW) post_row(p, l, row, t_ & 63);
        }
        grid.sync();
        for (int e_ = 0; e_ < PROBE_SYNC; ++e_) grid.sync();
    }
}

extern "C" void kernel_launch(void* const* d_in, const int* in_sizes, int n_in, void* d_out, int out_size, void* d_ws, size_t ws_size, hipStream_t stream) {
    Params p{};
    for (int i = 0; i < 14; ++i) p.in[i] = (const float*)d_in[i];
    p.xout = (float*)d_out; p.ws = (char*)d_ws;
    const size_t off = WS_END;
    static int grid_blocks = 0;
    if (!grid_blocks) {
        int dev = 0, cus = 0, per_cu = 0;
        (void)hipGetDevice(&dev);
        (void)hipDeviceGetAttribute(&cus, hipDeviceAttributeMultiprocessorCount, dev);
        (void)hipFuncSetAttribute((const void*)mega, hipFuncAttributeMaxDynamicSharedMemorySize, SMEM_BYTES);
        (void)hipOccupancyMaxActiveBlocksPerMultiprocessor(&per_cu, (const void*)mega, 512, SMEM_BYTES);
        if (per_cu < 1) fprintf(stderr, "occupancy query says %d blocks per CU\n", per_cu);
        grid_blocks = cus;
        if (off > ws_size) fprintf(stderr, "workspace too small: need %zu have %zu\n", off, ws_size);
    }
    void* args[] = {&p};
    hipError_t e = hipLaunchCooperativeKernel((void*)mega, dim3(grid_blocks), dim3(512), args, SMEM_BYTES, stream);
    if (e != hipSuccess) fprintf(stderr, "cooperative launch failed: %s (grid %d)\n", hipGetErrorString(e), grid_blocks);
}
```

```cpp
#include <hip/hip_runtime.h>
#include <hip/hip_cooperative_groups.h>
#include <stdint.h>
#include <cstdio>
namespace cg = cooperative_groups;

typedef unsigned short bf16_t;
#define DI __device__ __forceinline__

DI float bf2f(bf16_t v) { return __uint_as_float(((unsigned)v) << 16); }
DI bf16_t f2bf(float f) { unsigned u = __float_as_uint(f); u += 0x7fffu + ((u >> 16) & 1u); return (bf16_t)(u >> 16); }
DI float bflo(unsigned w) { return __uint_as_float(w << 16); }
DI float bfhi(unsigned w) { return __uint_as_float(w & 0xffff0000u); }
DI unsigned pk2(float lo, float hi) { return (unsigned)f2bf(lo) | ((unsigned)f2bf(hi) << 16); }

constexpr int NB = 4, T = 4096, D = 1024, NTOK = NB * T, DEPTH = 4, DIN = 2732, NP = 2816;
constexpr int C_AQ = 0, C_KCMP = 256, C_VCMP = 320, C_KSLC = 384, C_VSLC = 448, C_KWIN = 512, C_VWIN = 576, C_CK = 640, C_CV = 704;
constexpr int C_BCQ = 768, C_BCKV = 1024, C_BKR = 1152, C_AG = 1184, C_CQ = 1280, C_Z = 1792;
constexpr int BT_STRIDE = 520;

__host__ __device__ inline int src_col(int n) {
    if (n < 640) return n;
    if (n < 768) return 1580 + (n - 640);
    if (n < 1024) return 652 + (n - 768);
    if (n < 1152) return 908 + (n - 1024);
    if (n < 1184) return 1036 + (n - 1152);
    if (n < 1196) return 640 + (n - 1184);
    if (n < 1280) return -1;
    if (n < 1792) return 1068 + (n - 1280);
    return 1708 + (n - 1792);
}

DI int t5_bucket(int d) {
    if (d < 16) return d < 0 ? 0 : d;
    int b = 16;
    b += d >= 20; b += d >= 25; b += d >= 31; b += d >= 39; b += d >= 48; b += d >= 59; b += d >= 73; b += d >= 91;
    b += d >= 113; b += d >= 140; b += d >= 174; b += d >= 216; b += d >= 268; b += d >= 332; b += d >= 413;
    return b;
}

constexpr size_t al256(size_t x) { return (x + 255) & ~(size_t)255; }
constexpr size_t WS_P = 0;
constexpr size_t WS_XB = WS_P + al256((size_t)NTOK * NP * 2 + 65536);
constexpr size_t WS_WTIN = WS_XB + al256((size_t)NTOK * D * 2);
constexpr size_t WS_WTOUT = WS_WTIN + al256((size_t)DEPTH * NP * D * 2);
constexpr size_t WS_QM = WS_WTOUT + al256((size_t)DEPTH * D * D * 2);
constexpr size_t WS_KM = WS_QM + al256((size_t)NTOK * 384 * 2);
constexpr size_t WS_VM = WS_KM + al256((size_t)NTOK * 384 * 2);
constexpr size_t WS_MIX = WS_VM + al256((size_t)NTOK * 256 * 2);
constexpr size_t WS_OA = WS_MIX + al256((size_t)NTOK * 1024 * 2);
constexpr size_t WS_RS = WS_OA + al256((size_t)NTOK * 256 * 4);
constexpr size_t WS_SSQQ = WS_RS + al256((size_t)NTOK * 4);
constexpr size_t WS_SSQKV = WS_SSQQ + al256((size_t)NTOK * 16);
constexpr size_t WS_KC = WS_SSQKV + al256((size_t)NTOK * 16);
constexpr size_t WS_VC = WS_KC + al256((size_t)NB * 256 * 64 * 4);
constexpr size_t WS_SEL = WS_VC + al256((size_t)NB * 256 * 64 * 4);
constexpr size_t WS_BTAB = WS_SEL + al256((size_t)NTOK * 8);
constexpr size_t WS_WUQ = WS_BTAB + al256((size_t)12 * BT_STRIDE * 4);
constexpr size_t WS_WUKV = WS_WUQ + al256((size_t)DEPTH * 512 * 256 * 2);
constexpr size_t WS_W1T = WS_WUKV + al256((size_t)DEPTH * 512 * 128 * 2);
constexpr size_t WS_W2T = WS_W1T + al256((size_t)DEPTH * 2 * 128 * 2048 * 2);
constexpr size_t WS_BVEC = WS_W2T + al256((size_t)DEPTH * 2 * 64 * 128 * 2);
constexpr size_t WS_ROPE = WS_BVEC + al256((size_t)DEPTH * 2 * 128 * 4);
constexpr size_t WS_BAR = WS_ROPE + al256((size_t)T * 16 * 8);
constexpr size_t WS_END = WS_BAR + al256((size_t)3456 * 4);

struct Params {
    const float* in[14]; float* xout; char* ws;
#define PF(name, idx) DI const float* name() const { return in[idx]; }
    PF(x_in_, 0) PF(w_in_, 1) PF(w_out_, 2) PF(norm_pre_, 3) PF(norm_post_, 4) PF(cmp_pos_, 5) PF(cmp_w1_, 6) PF(cmp_w2_, 7) PF(q_norm_, 8) PF(w_uq_, 9) PF(kv_norm_, 10) PF(w_ukv_, 11) PF(sinks_, 12) PF(rel_bias_, 13)
#undef PF
};
#define x_in x_in_()
#define w_in w_in_()
#define w_out w_out_()
#define norm_pre norm_pre_()
#define norm_post norm_post_()
#define cmp_pos cmp_pos_()
#define cmp_w1 cmp_w1_()
#define cmp_w2 cmp_w2_()
#define q_norm q_norm_()
#define w_uq w_uq_()
#define kv_norm kv_norm_()
#define w_ukv w_ukv_()
#define sinks sinks_()
#define rel_bias rel_bias_()

namespace pg8 {
#define PG8_LAS __attribute__((address_space(3)))
typedef short bf16x8 __attribute__((ext_vector_type(8)));
typedef float f32x4 __attribute__((ext_vector_type(4)));
typedef unsigned u32x4 __attribute__((ext_vector_type(4)));
constexpr int BM = 256, BK = 64, HALF = 128, HTB = HALF * BK * 2  , STAGE_BYTES = 8 * HTB, NXCD = 8, WGM = 8;

__host__ __device__ __forceinline__ int lds_byte(int r, int c) { const int st = (r >> 4) * 2 + (c >> 5), rr = r & 15, cc = c & 31, ob = rr * 64 + cc * 2; return st * 1024 + (ob ^ (((ob >> 9) & 1) << 5)); }
__host__ __device__ __forceinline__ void stage_rc(int b, int& R, int& C) { const int st = b / 1024, sb = b % 1024, swz = sb ^ (((sb >> 9) & 1) << 5); R = (st >> 1) * 16 + swz / 64; C = (st & 1) * 32 + (swz % 64) / 2; }
__host__ __device__ __forceinline__ int perm32(int rho) { const int n = rho >> 4, i = rho & 15; return 8 * (i >> 2) + 4 * n + (i & 3); }

struct Unit { int pm, pn; };
struct Gemm { const bf16_t* A; const bf16_t* Bt; int M, N, K, lda; };

struct StaticOrder {
    int nM, nN, nwg, G, c;
    __host__ __device__ void init(int M, int N, int G_, int c_) { nM = M / BM; nN = N / BM; nwg = nM * nN; G = G_; c = c_; }
    __host__ __device__ bool next(int i, Unit& u) const {
        const long L = (long)i * G + c; if (L >= nwg) return false;
        int wgid = (int)L; { const int q = nwg / NXCD, r = nwg % NXCD, xcd = wgid % NXCD, off = wgid / NXCD; wgid = (xcd < r ? xcd * (q + 1) : r * (q + 1) + (xcd - r) * q) + off; }
        const int nig = WGM * nN, gid = wgid / nig, fm = gid * WGM, gsz = (nM - fm) < WGM ? (nM - fm) : WGM;
        u.pm = fm + ((wgid % nig) % gsz); u.pn = (wgid % nig) / gsz; return true;
    }
    __device__ __forceinline__ void a_ready(const Unit&) const {}
    __device__ __forceinline__ void done(const Unit&) const {}
};

template <class Epi, class Sched, bool ALIGN_EPI = false, bool SP2 = false>
__device__ __forceinline__ void gemm_phase(const int tid, PG8_LAS unsigned char* lds, const Gemm g, const Sched& S, const Epi& E) {
    const int wid = __builtin_amdgcn_readfirstlane(tid >> 6), lane = tid & 63, wr = wid >> 2, wc = wid & 3, fr = lane & 15, fq = lane >> 4;
    const int K = g.K, nt = K / BK, lda = g.lda;
    unsigned voffA, voffB;
    { int R, C; stage_rc(tid * 16, R, C); const int Rb = Epi::PERM ? ((R & ~31) + perm32(R & 31)) : R;
      voffA = (unsigned)(R * lda + C) * 2u; voffB = (unsigned)(Rb * K + C) * 2u; }
    const size_t pvoffA = (size_t)64 * lda * 2, pvoffB = (size_t)64 * K * 2;
    const size_t kstep = (size_t)(BK * 2);
    const size_t hstepA = (size_t)HALF * lda * 2, hstepB = (size_t)HALF * K * 2;
    const size_t tstepA = 2 * hstepA, tstepB = 2 * hstepB;
    const unsigned ldsw = (unsigned)wid * 1024u;
    const int aoff = lds_byte(wr * 64 + fr, fq * 8), boff = lds_byte(wc * 32 + fr, fq * 8);
#define PG8_SA(b, h) (((b) * 2 + (h)) * HTB)
#define PG8_SB(b, h) ((4 + (b) * 2 + (h)) * HTB)
#define PG8_STAGE(bufoff, gbase, voff) do { _Pragma("unroll") for (int _i = 0; _i < 2; ++_i) \
        __builtin_amdgcn_global_load_lds((const unsigned*)((const char*)(gbase) + _i * p##voff + (voff)), (PG8_LAS unsigned*)(lds + (bufoff) + ldsw + _i * 8192), 16, 0, 0); } while (0)
#define PG8_LDA(dst, b, h) do { _Pragma("unroll") for (int m = 0; m < 4; ++m) _Pragma("unroll") for (int k = 0; k < 2; ++k) dst[m][k] = *(const PG8_LAS bf16x8*)(lds + PG8_SA(b, h) + aoff + m * 2048 + k * 1024); } while (0)
#define PG8_LDB(dst, b, h) do { _Pragma("unroll") for (int n = 0; n < 2; ++n) _Pragma("unroll") for (int k = 0; k < 2; ++k) dst[n][k] = *(const PG8_LAS bf16x8*)(lds + PG8_SB(b, h) + boff + n * 2048 + k * 1024); } while (0)
#define PG8_MMA(ai, bj, At, Bt) do { __builtin_amdgcn_s_setprio(1); _Pragma("unroll") for (int m = 0; m < 4; ++m) _Pragma("unroll") for (int n = 0; n < 2; ++n) _Pragma("unroll") for (int k = 0; k < 2; ++k) \
        acc[ai][bj][m][n] = __builtin_amdgcn_mfma_f32_16x16x32_bf16(Bt[n][k], At[m][k], acc[ai][bj][m][n], 0, 0, 0); __builtin_amdgcn_s_setprio(0); } while (0)
#define PG8_WAIT_V(n) asm volatile("s_waitcnt vmcnt(" #n ")" ::: "memory")
#define PG8_WAIT_L(n) asm volatile("s_waitcnt lgkmcnt(" #n ")" ::: "memory")
#define PG8_BAR __builtin_amdgcn_s_barrier()
#define PG8_SCHED __builtin_amdgcn_sched_barrier(0)
    Unit cur, nxt; int ui = 0;
    if (!S.next(0, cur)) return;
    f32x4 acc[2][2][4][2];
#pragma unroll
    for (int a = 0; a < 2; ++a)
#pragma unroll
        for (int b = 0; b < 2; ++b)
#pragma unroll
            for (int m = 0; m < 4; ++m)
#pragma unroll
                for (int n = 0; n < 2; ++n) acc[a][b][m][n] = (f32x4){0.f, 0.f, 0.f, 0.f};
    bf16x8 At[4][2], B0[2][2], B1[2][2];
    const char* cA = (const char*)g.A + (size_t)cur.pm * tstepA; const char* cB = (const char*)g.Bt + (size_t)cur.pn * tstepB;
    S.a_ready(cur);
    if constexpr (SP2) {
        PG8_STAGE(PG8_SB(0, 0), cB, voffB); PG8_STAGE(PG8_SB(0, 1), cB + hstepB, voffB); PG8_STAGE(PG8_SA(0, 0), cA, voffA); PG8_STAGE(PG8_SA(0, 1), cA + hstepA, voffA);
        if (wr == 1) PG8_BAR;
        PG8_WAIT_V(2); PG8_BAR;
        PG8_STAGE(PG8_SB(1, 0), cB + kstep, voffB); PG8_STAGE(PG8_SA(1, 0), cA + kstep, voffA); PG8_STAGE(PG8_SB(1, 1), cB + hstepB + kstep, voffB);
        PG8_WAIT_V(6); PG8_BAR;
    } else {
        PG8_STAGE(PG8_SB(0, 0), cB, voffB); PG8_STAGE(PG8_SA(0, 0), cA, voffA); PG8_STAGE(PG8_SB(0, 1), cB + hstepB, voffB); PG8_STAGE(PG8_SA(0, 1), cA + hstepA, voffA);
        if (wr == 1) PG8_BAR;
        PG8_WAIT_V(4); PG8_BAR;
        PG8_STAGE(PG8_SB(1, 0), cB + kstep, voffB); PG8_STAGE(PG8_SA(1, 0), cA + kstep, voffA); PG8_STAGE(PG8_SB(1, 1), cB + hstepB + kstep, voffB);
        PG8_WAIT_V(6); PG8_BAR;
    }
    for (;;) {
        const bool has_next = S.next(ui + 1, nxt);
        const char* nA = has_next ? (const char*)g.A + (size_t)nxt.pm * tstepA : cA; const char* nB = has_next ? (const char*)g.Bt + (size_t)nxt.pn * tstepB : cB;
        for (int t = 0; t < nt; t += 2) {
            const bool last = (t == nt - 2);
            const char* a1 = cA + (size_t)(t + 1) * kstep;
            const char* a2 = last ? nA : cA + (size_t)(t + 2) * kstep; const char* b2 = last ? nB : cB + (size_t)(t + 2) * kstep;
            const char* a3 = a2 + kstep; const char* b3 = b2 + kstep;
            if (last && has_next) S.a_ready(nxt);
            if constexpr (SP2) {
            PG8_LDB(B0, 0, 0); PG8_LDB(B1, 0, 1); PG8_SCHED; PG8_LDA(At, 0, 0); PG8_STAGE(PG8_SA(1, 1), a1 + hstepA, voffA);
            PG8_WAIT_V(8); PG8_WAIT_L(0); PG8_BAR; PG8_MMA(0, 0, At, B0); PG8_MMA(0, 1, At, B1); PG8_BAR; PG8_SCHED;
            PG8_LDA(At, 0, 1); PG8_STAGE(PG8_SB(0, 0), b2, voffB); PG8_STAGE(PG8_SB(0, 1), b2 + hstepB, voffB); PG8_STAGE(PG8_SA(0, 0), a2, voffA);
            PG8_WAIT_V(8); PG8_WAIT_L(0); PG8_BAR; PG8_MMA(1, 0, At, B0); PG8_MMA(1, 1, At, B1); PG8_BAR; PG8_SCHED;
            PG8_LDB(B0, 1, 0); PG8_LDB(B1, 1, 1); PG8_SCHED; PG8_LDA(At, 1, 0); PG8_STAGE(PG8_SA(0, 1), a2 + hstepA, voffA);
            PG8_WAIT_V(8); PG8_WAIT_L(0); PG8_BAR; PG8_MMA(0, 0, At, B0); PG8_MMA(0, 1, At, B1); PG8_BAR; PG8_SCHED;
            PG8_LDA(At, 1, 1); PG8_STAGE(PG8_SB(1, 0), b3, voffB); PG8_STAGE(PG8_SB(1, 1), b3 + hstepB, voffB); PG8_STAGE(PG8_SA(1, 0), a3, voffA);
            PG8_WAIT_V(8); PG8_WAIT_L(0); PG8_BAR; PG8_MMA(1, 0, At, B0); PG8_MMA(1, 1, At, B1); PG8_BAR; PG8_SCHED;
            } else {
            PG8_LDB(B0, 0, 0); PG8_SCHED; PG8_LDA(At, 0, 0); PG8_STAGE(PG8_SA(1, 1), a1 + hstepA, voffA);
            PG8_WAIT_L(8); PG8_BAR; PG8_WAIT_L(0); PG8_MMA(0, 0, At, B0); PG8_BAR; PG8_SCHED;
            PG8_LDB(B1, 0, 1); PG8_STAGE(PG8_SB(0, 0), b2, voffB);
            PG8_BAR; PG8_WAIT_L(0); PG8_MMA(0, 1, At, B1); PG8_BAR;
            PG8_LDA(At, 0, 1); PG8_STAGE(PG8_SA(0, 0), a2, voffA);
            PG8_BAR; PG8_WAIT_L(0); PG8_MMA(1, 0, At, B0); PG8_BAR; PG8_SCHED;
            PG8_STAGE(PG8_SB(0, 1), b2 + hstepB, voffB);
            PG8_WAIT_V(6); PG8_BAR; PG8_MMA(1, 1, At, B1); PG8_BAR;
            PG8_LDB(B0, 1, 0); PG8_SCHED; PG8_LDA(At, 1, 0); PG8_STAGE(PG8_SA(0, 1), a2 + hstepA, voffA);
            PG8_WAIT_L(8); PG8_BAR; PG8_WAIT_L(0); PG8_MMA(0, 0, At, B0); PG8_BAR; PG8_SCHED;
            PG8_LDB(B1, 1, 1); PG8_STAGE(PG8_SB(1, 0), b3, voffB);
            PG8_BAR; PG8_WAIT_L(0); PG8_MMA(0, 1, At, B1); PG8_BAR;
            PG8_LDA(At, 1, 1); PG8_STAGE(PG8_SA(1, 0), a3, voffA);
            PG8_BAR; PG8_WAIT_L(0); PG8_MMA(1, 0, At, B0); PG8_BAR; PG8_SCHED;
            PG8_STAGE(PG8_SB(1, 1), b3 + hstepB, voffB);
            PG8_WAIT_V(6); PG8_BAR; PG8_MMA(1, 1, At, B1); PG8_BAR;
            }
        }
        if constexpr (ALIGN_EPI) { if (wr == 0) PG8_BAR; }
        if constexpr (!Epi::AFTER_DRAIN) {
            unsigned ones_ = ~0u; asm volatile("" : "+s"(ones_)); const int ln_ = (int)__builtin_amdgcn_mbcnt_hi(ones_, __builtin_amdgcn_mbcnt_lo(ones_, 0u));
            E(acc, cur, wr, wc, ln_ & 15, ln_ >> 4); S.done(cur); }
        if (!has_next) break;
#pragma unroll
        for (int a = 0; a < 2; ++a)
#pragma unroll
            for (int b = 0; b < 2; ++b)
#pragma unroll
                for (int m = 0; m < 4; ++m)
#pragma unroll
                    for (int n = 0; n < 2; ++n) acc[a][b][m][n] = (f32x4){0.f, 0.f, 0.f, 0.f};
        cur = nxt; cA = nA; cB = nB; ++ui;
        if constexpr (ALIGN_EPI) { if (wr == 1) PG8_BAR; }
    }
    PG8_WAIT_V(0);
    if constexpr (!ALIGN_EPI) { if (wr == 0) PG8_BAR; }
    PG8_BAR;
    if constexpr (Epi::AFTER_DRAIN) { E.fused(acc, cur, wr, wc, fr, fq, lds, wid, lane); S.done(cur); }
#undef PG8_SA
#undef PG8_SB
#undef PG8_STAGE
#undef PG8_LDA
#undef PG8_LDB
#undef PG8_MMA
#undef PG8_WAIT_V
#undef PG8_WAIT_L
#undef PG8_BAR
#undef PG8_SCHED
}

struct EpiInProj {
    static constexpr bool PERM = true, AFTER_DRAIN = false;
    bf16_t* O; const float* rs; float* ssq_q; float* ssq_kv;
    __device__ __forceinline__ void operator()(const f32x4 (&acc)[2][2][4][2], const Unit& u, int wr, int wc, int fr, int fq) const {
        const int row0 = u.pm * BM + wr * 64 + fr, col0 = u.pn * BM + wc * 32 + 8 * fq;
#pragma unroll
        for (int ai = 0; ai < 2; ++ai)
#pragma unroll
            for (int m = 0; m < 4; ++m) {
                const int row = row0 + ai * HALF + m * 16; const float r = rs[row];
                bf16_t* rowp = O + (size_t)row * NP + col0; float ss[2];
#pragma unroll
                for (int bj = 0; bj < 2; ++bj) { const f32x4 v0 = acc[ai][bj][m][0] * r, v1 = acc[ai][bj][m][1] * r;
                    u32x4 w; w.x = pk2(v0[0], v0[1]); w.y = pk2(v0[2], v0[3]); w.z = pk2(v1[0], v1[1]); w.w = pk2(v1[2], v1[3]);
                    *(u32x4*)(rowp + bj * HALF) = w;
                    ss[bj] = (v0[0] * v0[0] + v0[1] * v0[1]) + (v0[2] * v0[2] + v0[3] * v0[3]) + (v1[0] * v1[0] + v1[1] * v1[1]) + (v1[2] * v1[2] + v1[3] * v1[3]); }
                if (u.pn == 3 || u.pn == 4) {
                    float s = u.pn == 3 ? ss[0] + ss[1] : ss[0];
                    s += __shfl_xor(s, 16); s += __shfl_xor(s, 32);
                    if (fq == 0) ((u.pn == 3 ? ssq_q : ssq_kv) + (size_t)row * 4)[wc] = s;
                }
            }
    }
};
struct EpiF32 {
    static constexpr bool PERM = false, AFTER_DRAIN = false;
    float* O; int ldc;
    __device__ __forceinline__ void operator()(const f32x4 (&acc)[2][2][4][2], const Unit& u, int wr, int wc, int fr, int fq) const {
        const int row0 = u.pm * BM + wr * 64 + fr, col0 = u.pn * BM + wc * 32 + 4 * fq;
#pragma unroll
        for (int ai = 0; ai < 2; ++ai)
#pragma unroll
            for (int m = 0; m < 4; ++m) { float* rowp = O + (size_t)(row0 + ai * HALF + m * 16) * ldc + col0;
#pragma unroll
                for (int bj = 0; bj < 2; ++bj)
#pragma unroll
                    for (int n = 0; n < 2; ++n) *(f32x4*)(rowp + bj * HALF + n * 16) = acc[ai][bj][m][n]; }
    }
};
struct EpiQ {
    static constexpr bool PERM = true, AFTER_DRAIN = false;
    bf16_t* Qm; const float* ssq; const float2* rope;
    __device__ __forceinline__ void operator()(const f32x4 (&acc)[2][2][4][2], const Unit& u, int wr, int wc, int fr, int fq) const {
        const int row0 = u.pm * BM + wr * 64 + fr;
#pragma unroll
        for (int ai = 0; ai < 2; ++ai)
#pragma unroll
            for (int m = 0; m < 4; ++m) {
                const int row = row0 + ai * HALF + m * 16;
                const f32x4 sq = *(const f32x4*)(ssq + (size_t)row * 4);
                const float r = rsqrtf(((sq[0] + sq[1]) + (sq[2] + sq[3])) * (1.f / 256.f) + 1e-6f);
#pragma unroll
                for (int bj = 0; bj < 2; ++bj) {
                    const int j0 = u.pn * BM + bj * HALF + wc * 32 + 8 * fq;
                    if (u.pn * BM + bj * HALF >= 384) continue;
                    float v[8];
#pragma unroll
                    for (int t = 0; t < 4; ++t) { v[t] = acc[ai][bj][m][0][t] * r; v[4 + t] = acc[ai][bj][m][1][t] * r; }
                    if (((j0 >> 5) % 3) == 2) {
                        const float2* cs = rope + (size_t)(row & (T - 1)) * 16 + 8 * (fq & 1);
#pragma unroll
                        for (int t = 0; t < 8; ++t) { const float o = __shfl_xor(v[t], 32); const float2 c2 = cs[t]; v[t] = fq < 2 ? v[t] * c2.x - o * c2.y : v[t] * c2.x + o * c2.y; }
                    }
                    u32x4 w; w.x = pk2(v[0], v[1]); w.y = pk2(v[2], v[3]); w.z = pk2(v[4], v[5]); w.w = pk2(v[6], v[7]);
                    *(u32x4*)(Qm + (size_t)row * 384 + j0) = w;
                }
            }
    }
};
struct EpiKV {
    static constexpr bool PERM = true, AFTER_DRAIN = false;
    bf16_t* Km; bf16_t* Vm; const float* ssq;
    __device__ __forceinline__ void operator()(const f32x4 (&acc)[2][2][4][2], const Unit& u, int wr, int wc, int fr, int fq) const {
        const int row0 = u.pm * BM + wr * 64 + fr;
#pragma unroll
        for (int ai = 0; ai < 2; ++ai)
#pragma unroll
            for (int m = 0; m < 4; ++m) {
                const int row = row0 + ai * HALF + m * 16;
                const f32x4 sq = *(const f32x4*)(ssq + (size_t)row * 4);
                const float r = rsqrtf(((sq[0] + sq[1]) + (sq[2] + sq[3])) * (1.f / 128.f) + 1e-6f);
#pragma unroll
                for (int bj = 0; bj < 2; ++bj) {
                    const int j0 = u.pn * BM + bj * HALF + wc * 32 + 8 * fq, h = j0 >> 7, e = j0 & 127;
                    const f32x4 v0 = acc[ai][bj][m][0] * r, v1 = acc[ai][bj][m][1] * r;
                    u32x4 w; w.x = pk2(v0[0], v0[1]); w.y = pk2(v0[2], v0[3]); w.z = pk2(v1[0], v1[1]); w.w = pk2(v1[2], v1[3]);
                    if (e < 64) *(u32x4*)(Km + (size_t)row * 384 + h * 96 + e) = w; else *(u32x4*)(Vm + (size_t)row * 256 + h * 64 + (e - 64)) = w;
                }
            }
    }
};
}

template <class ColFn>
DI void transpose_tile(const float* W, int ldw, const float* g, bf16_t* dst, int ldd, int n0, int k0, ColFn colfn, int tid, float* tile  ) {
    { const int k = tid >> 3, n8 = (tid & 7) * 8; const float gg = g ? g[k0 + k] : 1.f;
#pragma unroll
      for (int j = 0; j < 8; ++j) { const int sc = colfn(n0 + n8 + j); tile[k * 65 + n8 + j] = sc >= 0 ? W[(size_t)(k0 + k) * ldw + sc] * gg : 0.f; } }
    __syncthreads();
    { const int n = tid >> 3, k8 = (tid & 7) * 8; float v[8];
#pragma unroll
      for (int j = 0; j < 8; ++j) v[j] = tile[(k8 + j) * 65 + n];
      uint4 w; w.x = pk2(v[0], v[1]); w.y = pk2(v[2], v[3]); w.z = pk2(v[4], v[5]); w.w = pk2(v[6], v[7]);
      *(uint4*)(dst + (size_t)(n0 + n) * ldd + k0 + k8) = w; }
    __syncthreads();
}
struct ColIdent { int lim; DI int operator()(int n) const { return n < lim ? n : -1; } };
struct ColIn { DI int operator()(int n) const { return src_col(n); } };
DI void pro_weights(const Params& p, int bid, int G, int tid, char* smem) {
    float* tile = (float*)smem;
    constexpr int T_IN = DEPTH * (NP / 64) * (D / 64), T_OUT = DEPTH * (D / 64) * (D / 64), T_UQ = DEPTH * 8 * 4, T_UKV = DEPTH * 8 * 2, T_W1 = DEPTH * 2 * 2 * 32, T_W2 = DEPTH * 2 * 1 * 2;
    for (int it = bid; it < T_IN + T_OUT + T_UQ + T_UKV + T_W1 + T_W2; it += G) {
        int r = it;
        if (r < T_IN) { const int l = r / ((NP / 64) * 16), q = r % ((NP / 64) * 16), nt = q / 16, kt = q % 16;
            transpose_tile(p.w_in + (size_t)l * D * DIN, DIN, p.norm_pre + l * D, (bf16_t*)(p.ws + WS_WTIN) + (size_t)l * NP * D, D, nt * 64, kt * 64, ColIn{}, tid, tile); continue; } r -= T_IN;
        if (r < T_OUT) { const int l = r / 256, q = r % 256, nt = q / 16, kt = q % 16;
            transpose_tile(p.w_out + (size_t)l * D * D, D, nullptr, (bf16_t*)(p.ws + WS_WTOUT) + (size_t)l * D * D, D, nt * 64, kt * 64, ColIdent{D}, tid, tile); continue; } r -= T_OUT;
        if (r < T_UQ) { const int l = r / 32, q = r % 32, nt = q / 4, kt = q % 4;
            transpose_tile(p.w_uq + (size_t)l * 256 * 384, 384, p.q_norm + l * 256, (bf16_t*)(p.ws + WS_WUQ) + (size_t)l * 512 * 256, 256, nt * 64, kt * 64, ColIdent{384}, tid, tile); continue; } r -= T_UQ;
        if (r < T_UKV) { const int l = r / 16, q = r % 16, nt = q / 2, kt = q % 2;
            transpose_tile(p.w_ukv + (size_t)l * 128 * 512, 512, p.kv_norm + l * 128, (bf16_t*)(p.ws + WS_WUKV) + (size_t)l * 512 * 128, 128, nt * 64, kt * 64, ColIdent{512}, tid, tile); continue; } r -= T_UKV;
        if (r < T_W1) { const int lw = r / 64, q = r % 64, nt = q / 32, kt = q % 32;
            transpose_tile(p.cmp_w1 + (size_t)lw * 2048 * 128, 128, nullptr, (bf16_t*)(p.ws + WS_W1T) + (size_t)lw * 128 * 2048, 2048, nt * 64, kt * 64, ColIdent{128}, tid, tile); continue; } r -= T_W1;
        { const int lw = r / 2, kt = r % 2;
            transpose_tile(p.cmp_w2 + (size_t)lw * 128 * 64, 64, nullptr, (bf16_t*)(p.ws + WS_W2T) + (size_t)lw * 64 * 128, 128, 0, kt * 64, ColIdent{64}, tid, tile); }
    }
}
DI void pro_all(const Params& p, int gtid, int gsize) {
    for (int i = gtid; i < 12 * BT_STRIDE; i += gsize) { const int h = i / BT_STRIDE, d = i % BT_STRIDE; ((float*)(p.ws + WS_BTAB))[i] = p.rel_bias[h * 32 + t5_bucket(d)]; }
    for (int i = gtid; i < T * 16; i += gsize) { const int pos = i >> 4, k = i & 15; const float ang = (float)pos * powf(10000.0f, -(float)k / 16.0f); ((float2*)(p.ws + WS_ROPE))[i] = make_float2(cosf(ang), sinf(ang)); }
    for (int i = gtid; i < DEPTH * 2 * 128; i += gsize) { const int lw = i >> 7, n = i & 127; const float* pe = p.cmp_pos + (size_t)lw * 2048; const float* w1 = p.cmp_w1 + (size_t)lw * 2048 * 128 + n;
        float a = 0.f; for (int k = 0; k < 2048; ++k) a += pe[k] * w1[(size_t)k * 128]; ((float*)(p.ws + WS_BVEC))[i] = a; }
}
DI void pro_xrow(const Params& p, int row, int lane) {
    const float4* xp = (const float4*)(p.x_in + (size_t)row * D);
    float s = 0.f;
#pragma unroll
    for (int i = 0; i < 4; ++i) { const float4 v = xp[lane + 64 * i]; s += v.x * v.x + v.y * v.y + v.z * v.z + v.w * v.w;
        uint2 w; w.x = pk2(v.x, v.y); w.y = pk2(v.z, v.w); ((uint2*)(((bf16_t*)(p.ws + WS_XB)) + (size_t)row * D))[lane + 64 * i] = w; }
    for (int o = 32; o > 0; o >>= 1) s += __shfl_xor(s, o);
    if (lane == 0) ((float*)(p.ws + WS_RS))[row] = rsqrtf(s * (1.0f / D) + 1e-6f);
}
DI void post_row(const Params& p, int layer, int row, int lane) {
    const float* x = (layer == 0 ? p.x_in : p.xout) + (size_t)row * D;
    const float* y = ((float*)(p.ws + WS_P)) + (size_t)row * D;
    const float* g = p.norm_post + layer * D;
    float4 yv[4]; float s = 0.f;
#pragma unroll
    for (int i = 0; i < 4; ++i) { yv[i] = ((const float4*)y)[lane + 64 * i]; s += yv[i].x * yv[i].x + yv[i].y * yv[i].y + yv[i].z * yv[i].z + yv[i].w * yv[i].w; }
    for (int o = 32; o > 0; o >>= 1) s += __shfl_xor(s, o);
    const float r = rsqrtf(s * (1.f / D) + 1e-6f);
    float s2 = 0.f;
#pragma unroll
    for (int i = 0; i < 4; ++i) {
        const float4 xv = ((const float4*)x)[lane + 64 * i], gv = ((const float4*)g)[lane + 64 * i];
        float4 o; o.x = xv.x + yv[i].x * r * gv.x; o.y = xv.y + yv[i].y * r * gv.y; o.z = xv.z + yv[i].z * r * gv.z; o.w = xv.w + yv[i].w * r * gv.w;
        ((float4*)(p.xout + (size_t)row * D))[lane + 64 * i] = o;
        uint2 w; w.x = pk2(o.x, o.y); w.y = pk2(o.z, o.w); ((uint2*)(((bf16_t*)(p.ws + WS_XB)) + (size_t)row * D))[lane + 64 * i] = w;
        s2 += o.x * o.x + o.y * o.y + o.z * o.z + o.w * o.w;
    }
    for (int o = 32; o > 0; o >>= 1) s2 += __shfl_xor(s2, o);
    if (lane == 0) ((float*)(p.ws + WS_RS))[row] = rsqrtf(s2 * (1.f / D) + 1e-6f);
}

namespace att {
#define ALAS __attribute__((address_space(3)))
typedef short bf16x8 __attribute__((ext_vector_type(8)));
typedef short s16x4 __attribute__((ext_vector_type(4)));
typedef short v4i16_t __attribute__((ext_vector_type(4)));
typedef float f32x16 __attribute__((ext_vector_type(16)));
typedef unsigned u32x4_t __attribute__((ext_vector_type(4)));
typedef float f32x2_t __attribute__((ext_vector_type(2)));
typedef __bf16 bf16x2_t __attribute__((ext_vector_type(2)));
constexpr float LOG2E = 1.4426950408889634f;
constexpr float NEGB = -1e30f;
constexpr int DMAXT = 640, TABN = 712;

DI unsigned cvtpk(float lo, float hi) { f32x2_t v = {lo, hi}; bf16x2_t b = __builtin_convertvector(v, bf16x2_t); return __builtin_bit_cast(unsigned, b); }
DI s16x4 vtr(const ALAS char* p) { return __builtin_bit_cast(s16x4, __builtin_amdgcn_ds_read_tr16_b64_v4i16((ALAS v4i16_t*)p)); }
DI bf16x8 pack8(const f32x16& x, int s8) {
    u32x4_t w; w.x = cvtpk(x[s8 + 0], x[s8 + 1]); w.y = cvtpk(x[s8 + 2], x[s8 + 3]); w.z = cvtpk(x[s8 + 4], x[s8 + 5]); w.w = cvtpk(x[s8 + 6], x[s8 + 7]);
    return __builtin_bit_cast(bf16x8, w);
}
template <int DK> DI void k_offsets(int lane, unsigned (&ko)[DK / 16]) {
    const int r32 = lane & 31, hi = lane >> 5;
    const int x = (DK == 64) ? ((r32 >> 1) & 7) : ((r32 >> 2) & 3);
#pragma unroll
    for (int ks = 0; ks < DK / 16; ++ks) ko[ks] = (unsigned)(r32 * (DK * 2) + 16 * ((2 * ks + hi) ^ x));
}
DI void v_offsets(int lane, unsigned (&vo)[2]) {
    const int hi = lane >> 5, qp = (lane & 15) >> 2, sft = qp >> 1, d0 = 16 * ((lane >> 4) & 1) + 4 * (lane & 3);
#pragma unroll
    for (int db = 0; db < 2; ++db) vo[db] = (unsigned)((4 * hi + qp) * 128 + 64 * (db ^ sft) + 2 * d0);
}
DI unsigned k64_dst(int row, int ch) { return (unsigned)(row * 128 + 16 * (ch ^ ((row >> 1) & 7))); }
DI unsigned k96_dst(int row, int ch) { return (unsigned)(row * 192 + 16 * (ch ^ ((row >> 2) & 3))); }
DI unsigned v64_dst(int row, int ch) { return (unsigned)(row * 128 + 16 * (ch ^ (((row >> 1) & 1) << 2))); }

template <int DK, int MODE>
DI void tile_step(const ALAS char* kt, const ALAS char* vt, const unsigned (&ko)[DK / 16], const unsigned (&vo)[2], const bf16x8 (&qf)[DK / 16],
                  float c, float cb, const ALAS float* tb, float& m, float& l, f32x16 (&o)[2]) {
    f32x16 s0, s1;
#pragma unroll
    for (int r = 0; r < 16; ++r) { s0[r] = 0.f; s1[r] = 0.f; }
#pragma unroll
    for (int ks = 0; ks < DK / 16; ++ks) {
        const bf16x8 k0 = *(const ALAS bf16x8*)(kt + ko[ks]);
        const bf16x8 k1 = *(const ALAS bf16x8*)(kt + ko[ks] + 32 * DK * 2);
        s0 = __builtin_amdgcn_mfma_f32_32x32x16_bf16(k0, qf[ks], s0, 0, 0, 0);
        s1 = __builtin_amdgcn_mfma_f32_32x32x16_bf16(k1, qf[ks], s1, 0, 0, 0);
    }
    __builtin_amdgcn_sched_barrier(0);
    if (MODE == 0) {
#pragma unroll
        for (int r = 0; r < 16; ++r) { s0[r] = __builtin_fmaf(s0[r], c, cb); s1[r] = __builtin_fmaf(s1[r], c, cb); }
    } else {
#pragma unroll
        for (int r = 0; r < 16; ++r) { const int e = (r & 3) + 8 * (r >> 2); s0[r] = __builtin_fmaf(s0[r], c, tb[e]); s1[r] = __builtin_fmaf(s1[r], c, tb[32 + e]); }
    }
    float mt = __builtin_fmaxf(s0[0], s1[0]);
#pragma unroll
    for (int r = 1; r < 16; ++r) mt = __builtin_fmaxf(mt, __builtin_fmaxf(s0[r], s1[r]));
    mt = __builtin_fmaxf(mt, __shfl_xor(mt, 32));
    if (__any(mt > m)) {
        const float mn = __builtin_fmaxf(m, mt), a = __builtin_amdgcn_exp2f(m - mn);
        m = mn; l *= a;
#pragma unroll
        for (int r = 0; r < 16; ++r) { o[0][r] *= a; o[1][r] *= a; }
    }
    float rs = 0.f;
#pragma unroll
    for (int r = 0; r < 16; ++r) { s0[r] = __builtin_amdgcn_exp2f(s0[r] - m); s1[r] = __builtin_amdgcn_exp2f(s1[r] - m); rs += s0[r] + s1[r]; }
    l += rs;
    bf16x8 pf[4];
    pf[0] = pack8(s0, 0); pf[1] = pack8(s0, 8); pf[2] = pack8(s1, 0); pf[3] = pack8(s1, 8);
    __builtin_amdgcn_sched_barrier(0);
#pragma unroll
    for (int db = 0; db < 2; ++db)
#pragma unroll
        for (int kk = 0; kk < 4; ++kk) {
            const s16x4 lo = vtr(vt + vo[db] + kk * 2048), hh = vtr(vt + vo[db] + kk * 2048 + 1024);
            const bf16x8 vf = (bf16x8){lo[0], lo[1], lo[2], lo[3], hh[0], hh[1], hh[2], hh[3]};
            o[db] = __builtin_amdgcn_mfma_f32_32x32x16_bf16(vf, pf[kk], o[db], 0, 0, 0);
        }
    __builtin_amdgcn_sched_barrier(0);
}

constexpr int L_K0 = 0, L_K1 = 12288, L_V0 = 24576, L_V1 = 32768, L_TAB = 40960;

DI void build_table(ALAS float* A, const float* bt, int W, int tid, int nthreads) {
    for (int i = tid; i < TABN; i += nthreads) { const int d = DMAXT - i; float v = NEGB; if (d >= 0 && d < W) v = bt ? LOG2E * bt[d < 512 ? d : 512] : 0.f; A[i] = v; }
}

DI void store_mixed(const Params& p, const f32x16 (&acc)[2], size_t tok, int mcol, int hi);
DI void mla_unit(const Params& p, int tid, ALAS char* lds, int b, int h, int qt) {
    const int lane = tid & 63, w = __builtin_amdgcn_readfirstlane(tid >> 6), r32 = lane & 31, hi = lane >> 5;
    const int tq = 256 * qt + 32 * w + r32;
    const bf16_t* Qm = (const bf16_t*)(p.ws + WS_QM); const bf16_t* Km = (const bf16_t*)(p.ws + WS_KM); const bf16_t* Vm = (const bf16_t*)(p.ws + WS_VM);
    bf16x8 qf[6];
    { const bf16_t* qrow = Qm + ((size_t)b * T + tq) * 384 + h * 96;
#pragma unroll
      for (int ks = 0; ks < 6; ++ks) qf[ks] = *(const bf16x8*)(qrow + 16 * ks + 8 * hi); }
    unsigned ko[6], vo[2]; k_offsets<96>(lane, ko); v_offsets(lane, vo);
    f32x16 o[2];
#pragma unroll
    for (int r = 0; r < 16; ++r) { o[0][r] = 0.f; o[1][r] = 0.f; }
    float m = NEGB, l = 0.f;
    const float c = 0.10206207261596577f * LOG2E;
    const int ntiles = 4 * qt + 4, mylast = 4 * qt + (w >> 1);
    const ALAS float* tabA = (const ALAS float*)(lds + L_TAB);
    const int kr0 = tid / 12, kc0 = tid % 12, kr1 = (tid + 512) / 12, kc1 = (tid + 512) % 12, vr = tid >> 3, vc = tid & 7;
    const bf16_t* ksrc0 = Km + ((size_t)b * T + kr0) * 384 + h * 96 + kc0 * 8;
    const bf16_t* ksrc1 = Km + ((size_t)b * T + kr1) * 384 + h * 96 + kc1 * 8;
    const bf16_t* vsrc = Vm + ((size_t)b * T + vr) * 256 + h * 64 + vc * 8;
    const unsigned kd0 = k96_dst(kr0, kc0), kd1 = k96_dst(kr1, kc1), vd = v64_dst(vr, vc);
    u32x4_t ka, kb = (u32x4_t){0u, 0u, 0u, 0u}, va;
    ka = *(const u32x4_t*)ksrc0; if (tid < 256) kb = *(const u32x4_t*)ksrc1; va = *(const u32x4_t*)vsrc;
    *(ALAS u32x4_t*)(lds + L_K0 + kd0) = ka; if (tid < 256) *(ALAS u32x4_t*)(lds + L_K0 + kd1) = kb; *(ALAS u32x4_t*)(lds + L_V0 + vd) = va;
    __syncthreads();
    for (int jt = 0; jt < ntiles; ++jt) {
        const int cur = jt & 1;
        if (jt + 1 < ntiles) { const size_t adv = (size_t)(jt + 1) * 64;
            ka = *(const u32x4_t*)(ksrc0 + adv * 384); if (tid < 256) kb = *(const u32x4_t*)(ksrc1 + adv * 384); va = *(const u32x4_t*)(vsrc + adv * 256); }
        if (jt <= mylast) {
            const ALAS char* kt = lds + (cur ? L_K1 : L_K0); const ALAS char* vt = lds + (cur ? L_V1 : L_V0);
            if (jt == mylast) { const int D0 = tq - 64 * jt - 4 * hi; tile_step<96, 1>(kt, vt, ko, vo, qf, c, 0.f, tabA + (DMAXT - D0), m, l, o); }
            else tile_step<96, 0>(kt, vt, ko, vo, qf, c, 0.f, tabA, m, l, o);
        }
        if (jt + 1 < ntiles) { ALAS char* kn = lds + (cur ? L_K0 : L_K1); ALAS char* vn = lds + (cur ? L_V0 : L_V1);
            *(ALAS u32x4_t*)(kn + kd0) = ka; if (tid < 256) *(ALAS u32x4_t*)(kn + kd1) = kb; *(ALAS u32x4_t*)(vn + vd) = va; }
        __syncthreads();
    }
    l += __shfl_xor(l, 32);
    { const float invl = 1.f / l;
#pragma unroll
      for (int r = 0; r < 16; ++r) { o[0][r] *= invl; o[1][r] *= invl; } }
    store_mixed(p, o, (size_t)b * T + tq, 256 + 64 * h, hi);
}
DI void acc_scaled(f32x16 (&acc)[2], const f32x16 (&o)[2], float f) {
#pragma unroll
    for (int r = 0; r < 16; ++r) { acc[0][r] += f * o[0][r]; acc[1][r] += f * o[1][r]; }
}
DI void store_mixed(const Params& p, const f32x16 (&acc)[2], size_t tok, int mcol, int hi) {
    const bf16_t* zp = (const bf16_t*)(p.ws + WS_P) + tok * NP + C_Z + mcol;
    bf16_t* mp = (bf16_t*)(p.ws + WS_MIX) + tok * 1024 + mcol;
    float one = 1.f; asm volatile("" : "+v"(one));
#pragma unroll
    for (int db = 0; db < 2; ++db)
#pragma unroll
        for (int g = 0; g < 4; ++g) {
            const int d = 32 * db + 8 * g + 4 * hi;
            const uint2 zw = *(const uint2*)(zp + d);
            const float z0 = bflo(zw.x), z1 = bfhi(zw.x), z2 = bflo(zw.y), z3 = bfhi(zw.y);
            const float v0 = acc[db][4 * g + 0] * z0 / (one + __expf(-z0)), v1 = acc[db][4 * g + 1] * z1 / (one + __expf(-z1));
            const float v2 = acc[db][4 * g + 2] * z2 / (one + __expf(-z2)), v3 = acc[db][4 * g + 3] * z3 / (one + __expf(-z3));
            uint2 ow; ow.x = cvtpk(v0, v1); ow.y = cvtpk(v2, v3);
            *(uint2*)(mp + d) = ow;
        }
}
DI void zero2(f32x16 (&o)[2]) {
#pragma unroll
    for (int r = 0; r < 16; ++r) { o[0][r] = 0.f; o[1][r] = 0.f; }
}
struct Stage64 {
    const bf16_t* ks; const bf16_t* vs; unsigned kd, vd; u32x4_t ka, va;
    DI void init(const bf16_t* kbase, const bf16_t* vbase, size_t pitch, int tid) { const int row = tid >> 3, ch = tid & 7; ks = kbase + row * pitch + ch * 8; vs = vbase + row * pitch + ch * 8; kd = k64_dst(row, ch); vd = v64_dst(row, ch); }
    DI void load(size_t rowoff_elems) { ka = *(const u32x4_t*)(ks + rowoff_elems); va = *(const u32x4_t*)(vs + rowoff_elems); }
    DI void store(ALAS char* kb, ALAS char* vb) const { *(ALAS u32x4_t*)(kb + kd) = ka; *(ALAS u32x4_t*)(vb + vd) = va; }
};

DI void swa_unit(const Params& p, int tid, ALAS char* lds, int layer, int b, int qt) {
    const int lane = tid & 63, w = __builtin_amdgcn_readfirstlane(tid >> 6), r32 = lane & 31, hi = lane >> 5;
    const int tq = 32 * qt + r32; const size_t tok = (size_t)b * T + tq;
    const bf16_t* P = (const bf16_t*)(p.ws + WS_P);
    bf16x8 qf[4];
#pragma unroll
    for (int ks = 0; ks < 4; ++ks) qf[ks] = *(const bf16x8*)(P + tok * NP + C_CQ + 64 * w + 16 * ks + 8 * hi);
    unsigned ko[4], vo[2]; k_offsets<64>(lane, ko); v_offsets(lane, vo);
    f32x16 o[2]; zero2(o);
    float m = NEGB, l = 0.f;
    const float c = 0.125f * LOG2E;
    const int jd = qt >> 1, ntl = jd + 1 < 3 ? jd + 1 : 3;
    const ALAS float* tab = (const ALAS float*)(lds + L_TAB) + w * TABN;
    Stage64 st; st.init(P + (size_t)b * T * NP + C_CK, P + (size_t)b * T * NP + C_CV, NP, tid);
    st.load((size_t)(64 * jd) * NP); st.store(lds + L_K0, lds + L_V0);
    __syncthreads();
    for (int i = 0; i < ntl; ++i) {
        const int cur = i & 1, jt = jd - i;
        if (i + 1 < ntl) st.load((size_t)(64 * (jt - 1)) * NP);
        { const int D0 = tq - 64 * jt - 4 * hi;
          tile_step<64, 1>(lds + (cur ? L_K1 : L_K0), lds + (cur ? L_V1 : L_V0), ko, vo, qf, c, 0.f, tab + (DMAXT - D0), m, l, o); }
        if (i + 1 < ntl) st.store(lds + (cur ? L_K0 : L_K1), lds + (cur ? L_V0 : L_V1));
        __syncthreads();
    }
    l += __shfl_xor(l, 32);
    l += __builtin_amdgcn_exp2f(p.sinks[layer * 8 + w] * LOG2E - m);
    f32x16 acc[2]; zero2(acc); acc_scaled(acc, o, 1.f / l);
    store_mixed(p, acc, tok, 512 + 64 * w, hi);
}

template <bool FIRST> DI void oa_accum(float* oap, const f32x16 (&o)[2], float f, int hi) {
#pragma unroll
    for (int db = 0; db < 2; ++db)
#pragma unroll
        for (int g = 0; g < 4; ++g) {
            float4* q = (float4*)(oap + 32 * db + 8 * g + 4 * hi);
            float4 v = FIRST ? make_float4(0.f, 0.f, 0.f, 0.f) : *q;
            v.x += f * o[db][4 * g + 0]; v.y += f * o[db][4 * g + 1]; v.z += f * o[db][4 * g + 2]; v.w += f * o[db][4 * g + 3];
            *q = v;
        }
}
constexpr int L_TSEL = L_TAB, L_TWIN = L_TAB + 4 * TABN * 4, L_TCMP = L_TWIN + 4 * TABN * 4, CMPN = 520, L_IMP = 73728, L_SELM = L_IMP + 65536, L_UNION = L_SELM + 512;
DI void nsa_tables(const Params& p, int tid, ALAS char* lds) {
    const float* bt = (const float*)(p.ws + WS_BTAB);
    for (int h = 0; h < 4; ++h) {
        build_table((ALAS float*)(lds + L_TSEL) + h * TABN, bt + h * BT_STRIDE, 1 << 30, tid, 512);
        build_table((ALAS float*)(lds + L_TWIN) + h * TABN, bt + h * BT_STRIDE, 512, tid, 512);
        for (int i = tid; i < CMPN; i += 512) ((ALAS float*)(lds + L_TCMP))[h * CMPN + i] = i == 0 ? NEGB : LOG2E * bt[h * BT_STRIDE + (i - 1 < 512 ? i - 1 : 512)];
    }
}
DI void cmp_scores(const ALAS char* kt, const unsigned (&ko)[4], const bf16x8 (&qf)[4], float c, bool far, float cb31, const ALAS float* G, int D0c, f32x16& s0, f32x16& s1) {
#pragma unroll
    for (int r = 0; r < 16; ++r) { s0[r] = 0.f; s1[r] = 0.f; }
#pragma unroll
    for (int ks = 0; ks < 4; ++ks) {
        const bf16x8 k0 = *(const ALAS bf16x8*)(kt + ko[ks]);
        const bf16x8 k1 = *(const ALAS bf16x8*)(kt + ko[ks] + 32 * 128);
        s0 = __builtin_amdgcn_mfma_f32_32x32x16_bf16(k0, qf[ks], s0, 0, 0, 0);
        s1 = __builtin_amdgcn_mfma_f32_32x32x16_bf16(k1, qf[ks], s1, 0, 0, 0);
    }
    __builtin_amdgcn_sched_barrier(0);
    if (far) {
#pragma unroll
        for (int r = 0; r < 16; ++r) { s0[r] = __builtin_fmaf(s0[r], c, cb31); s1[r] = __builtin_fmaf(s1[r], c, cb31); }
    } else {
#pragma unroll
        for (int r = 0; r < 16; ++r) {
            const int e = (r & 3) + 8 * (r >> 2);
            int d0 = D0c - 16 * e, d1 = D0c - 16 * (e + 32);
            d0 = d0 < -1 ? -1 : (d0 > 512 ? 512 : d0); d1 = d1 < -1 ? -1 : (d1 > 512 ? 512 : d1);
            s0[r] = __builtin_fmaf(s0[r], c, G[d0 + 1]); s1[r] = __builtin_fmaf(s1[r], c, G[d1 + 1]);
        }
    }
}
DI void nsa_unit(const Params& p, int tid, ALAS char* lds, int b, int qt) {
    const int lane = tid & 63, w = __builtin_amdgcn_readfirstlane(tid >> 6), r32 = lane & 31, hi = lane >> 5;
    const int h = w & 3, th = w >> 2;
    const int tq = 64 * qt + 32 * th + r32; const size_t tok = (size_t)b * T + tq;
    const bf16_t* P = (const bf16_t*)(p.ws + WS_P);
    bf16x8 qf[4];
#pragma unroll
    for (int ks = 0; ks < 4; ++ks) qf[ks] = *(const bf16x8*)(P + tok * NP + C_AQ + 64 * h + 16 * ks + 8 * hi);
    unsigned ko[4], vo[2]; k_offsets<64>(lane, ko); v_offsets(lane, vo);
    const float c = 0.125f * LOG2E;
    const float* bt = (const float*)(p.ws + WS_BTAB) + h * BT_STRIDE;
    const float b31 = LOG2E * bt[512];
    float g0, g1, g2;
    { float one = 1.f; asm volatile("" : "+v"(one));
      const bf16_t* gp = P + tok * NP + C_AG + 3 * h; g0 = one / (one + __expf(-bf2f(gp[0]))); g1 = one / (one + __expf(-bf2f(gp[1]))); g2 = one / (one + __expf(-bf2f(gp[2]))); }
    float* oap = (float*)(p.ws + WS_OA) + tok * 256 + 64 * h;
    Stage64 st;
    const int nvmax = 4 * qt + 3 < 255 ? 4 * qt + 3 : 255, nct = (nvmax + 63) >> 6;
    const ALAS float* G = (const ALAS float*)(lds + L_TCMP) + h * CMPN;
    ALAS float* impw = (ALAS float*)(lds + L_IMP) + (h * 64 + 32 * th + r32) * 64;
    const int tqmin = 64 * qt + 32 * th;
    { float zf = 0.f; asm volatile("" : "+v"(zf));
#pragma unroll
      for (int i = 0; i < 32; ++i) impw[32 * hi + i] = zf; }
    st.init((const bf16_t*)(p.ws + WS_KC) + (size_t)b * 256 * 64, (const bf16_t*)(p.ws + WS_VC) + (size_t)b * 256 * 64, 64, tid);
    float m = NEGB, l = 0.f;
    for (int pass = 0; pass < 2; ++pass) {
        f32x16 o[2]; zero2(o);
        const float invl = (pass == 1 && tq >= 31) ? 1.f / l : 0.f;
        float carry = 0.f;
        __syncthreads();
        st.load(0); st.store(lds + L_K0, lds + L_V0);
        __syncthreads();
        for (int ct = 0; ct < nct; ++ct) {
            const int cur = ct & 1;
            if (ct + 1 < nct) st.load((size_t)(64 * (ct + 1)) * 64);
            const ALAS char* kt = lds + (cur ? L_K1 : L_K0); const ALAS char* vt = lds + (cur ? L_V1 : L_V0);
            const bool far = tqmin - (16 * (64 * ct + 63) + 31) >= 413;
            const int D0c = tq - 31 - 16 * (64 * ct) - 64 * hi;
            f32x16 s0, s1;
            cmp_scores(kt, ko, qf, c, far, b31, G, D0c, s0, s1);
            __builtin_amdgcn_sched_barrier(0);
            if (pass == 0) {
                float mt = __builtin_fmaxf(s0[0], s1[0]);
#pragma unroll
                for (int r = 1; r < 16; ++r) mt = __builtin_fmaxf(mt, __builtin_fmaxf(s0[r], s1[r]));
                mt = __builtin_fmaxf(mt, __shfl_xor(mt, 32));
                const float mn = __builtin_fmaxf(m, mt); l *= __builtin_amdgcn_exp2f(m - mn); m = mn;
                float rs = 0.f;
#pragma unroll
                for (int r = 0; r < 16; ++r) rs += __builtin_amdgcn_exp2f(s0[r] - m) + __builtin_amdgcn_exp2f(s1[r] - m);
                l += rs;
            } else {
#pragma unroll
                for (int r = 0; r < 16; ++r) { s0[r] = __builtin_amdgcn_exp2f(s0[r] - m) * invl; s1[r] = __builtin_amdgcn_exp2f(s1[r] - m) * invl; }
                bf16x8 pf[4];
                pf[0] = pack8(s0, 0); pf[1] = pack8(s0, 8); pf[2] = pack8(s1, 0); pf[3] = pack8(s1, 8);
                __builtin_amdgcn_sched_barrier(0);
                f32x16 im;
#pragma unroll
                for (int r = 0; r < 16; ++r) im[r] = 0.f;
#pragma unroll
                for (int kk = 0; kk < 4; ++kk) {
                    bf16x8 of;
#pragma unroll
                    for (int j = 0; j < 8; ++j) { const int cl = 16 * kk + 8 * (j >> 2) + 4 * hi + (j & 3); const int sb = cl >> 2; const bool last = (cl & 3) == 3;
                        of[j] = (short)(sb == r32 ? (last ? 0x3F80 : 0x4000) : ((last && sb + 1 == r32) ? 0x3F80 : 0)); }
                    im = __builtin_amdgcn_mfma_f32_32x32x16_bf16(of, pf[kk], im, 0, 0, 0);
#pragma unroll
                    for (int db = 0; db < 2; ++db) {
                        const s16x4 lo = vtr(vt + vo[db] + kk * 2048), hh = vtr(vt + vo[db] + kk * 2048 + 1024);
                        const bf16x8 vf = (bf16x8){lo[0], lo[1], lo[2], lo[3], hh[0], hh[1], hh[2], hh[3]};
                        o[db] = __builtin_amdgcn_mfma_f32_32x32x16_bf16(vf, pf[kk], o[db], 0, 0, 0);
                    }
                }
                __builtin_amdgcn_sched_barrier(0);
                if (hi == 0) {
                    im[0] += carry; carry = im[8];
#pragma unroll
                    for (int r = 0; r < 8; ++r) impw[16 * ct + (r & 3) + 8 * (r >> 2)] = im[r];
                    if (ct == nct - 1 && 16 * ct + 16 < 64) impw[16 * ct + 16] = im[8];
                } else {
#pragma unroll
                    for (int r = 0; r < 8; ++r) impw[16 * ct + 4 + (r & 3) + 8 * (r >> 2)] = im[r];
                }
            }
            if (ct + 1 < nct) st.store(lds + (cur ? L_K0 : L_K1), lds + (cur ? L_V0 : L_V1));
            __syncthreads();
        }
        if (pass == 0) l += __shfl_xor(l, 32);
        else oa_accum<true>(oap, o, g0, hi);
    }
    {
        const int tl = tid >> 3, sub = tid & 7, cur = qt;
        unsigned long long mask;
        if (cur + 1 <= 16) mask = (2ull << cur) - 1ull;
        else {
            float v[8];
            const ALAS float* ib = (const ALAS float*)(lds + L_IMP) + tl * 64 + sub * 8;
#pragma unroll
            for (int i = 0; i < 8; ++i) { const int s = sub * 8 + i; const float x = (ib[i] + ib[4096 + i]) + (ib[8192 + i] + ib[12288 + i]); v[i] = (s >= 1 && s <= cur - 2) ? x : -3e38f; }
            mask = 1ull | (1ull << cur) | (1ull << (cur - 1));
            for (int it = 0; it < 13; ++it) {
                float best = v[0]; int bi = 0;
#pragma unroll
                for (int i = 1; i < 8; ++i) if (v[i] > best) { best = v[i]; bi = i; }
                int bs = sub * 8 + bi;
#pragma unroll
                for (int off = 1; off < 8; off <<= 1) { const float ob = __shfl_xor(best, off); const int os = __shfl_xor(bs, off); if (ob > best || (ob == best && os < bs)) { best = ob; bs = os; } }
                if (best > -1e38f) { mask |= 1ull << bs;
#pragma unroll
                    for (int i = 0; i < 8; ++i) if (sub * 8 + i == bs) v[i] = -3e38f; }
            }
        }
        if (sub == 0) ((ALAS unsigned long long*)(lds + L_SELM))[tl] = mask;
        __syncthreads();
    }
    unsigned long long mymask = ((const ALAS unsigned long long*)(lds + L_SELM))[32 * th + r32];
    unsigned long long uni = 0ull;
    { const ALAS unsigned long long* sm = (const ALAS unsigned long long*)(lds + L_SELM);
      for (int i = 0; i < 64; ++i) uni |= sm[i]; }
    uni = ((unsigned long long)(unsigned)__builtin_amdgcn_readfirstlane((int)(uni >> 32)) << 32) | (unsigned)__builtin_amdgcn_readfirstlane((int)uni);
    {
        f32x16 o[2]; zero2(o); m = NEGB; l = 0.f;
        const ALAS float* tab = (const ALAS float*)(lds + L_TSEL) + h * TABN;
        st.init(P + (size_t)b * T * NP + C_KSLC, P + (size_t)b * T * NP + C_VSLC, NP, tid);
        unsigned long long rem = uni;
        int s = 63 - __builtin_clzll(rem); rem &= ~(1ull << s);
        st.load((size_t)(64 * s) * NP); st.store(lds + L_K0, lds + L_V0);
        __syncthreads();
        int cur = 0;
        for (;;) {
            const int sn = rem ? 63 - __builtin_clzll(rem) : -1;
            if (sn >= 0) { rem &= ~(1ull << sn); st.load((size_t)(64 * sn) * NP); }
            const bool mine = (mymask >> s) & 1ull;
            if (__any(mine)) {
                const ALAS char* kt = lds + (cur ? L_K1 : L_K0); const ALAS char* vt = lds + (cur ? L_V1 : L_V0);
                const int D0 = tq - 64 * s - 4 * hi;
                if (qt - s <= 7) tile_step<64, 1>(kt, vt, ko, vo, qf, c, 0.f, tab + (mine ? DMAXT - D0 : DMAXT + 1), m, l, o);
                else tile_step<64, 0>(kt, vt, ko, vo, qf, c, mine ? b31 : NEGB, tab, m, l, o);
            }
            if (sn >= 0) st.store(lds + (cur ? L_K0 : L_K1), lds + (cur ? L_V0 : L_V1));
            __syncthreads();
            if (sn < 0) break;
            s = sn; cur ^= 1;
        }
        l += __shfl_xor(l, 32);
        oa_accum<false>(oap, o, g1 / l, hi);
    }
    {
        f32x16 o[2]; zero2(o); m = NEGB; l = 0.f;
        const ALAS float* tab = (const ALAS float*)(lds + L_TWIN) + h * TABN;
        st.init(P + (size_t)b * T * NP + C_KWIN, P + (size_t)b * T * NP + C_VWIN, NP, tid);
        const int ntl = qt + 1 < 9 ? qt + 1 : 9;
        st.load((size_t)(64 * qt) * NP); st.store(lds + L_K0, lds + L_V0);
        __syncthreads();
        for (int i = 0; i < ntl; ++i) {
            const int cur = i & 1, jt = qt - i;
            if (i + 1 < ntl) st.load((size_t)(64 * (jt - 1)) * NP);
            { const int D0 = tq - 64 * jt - 4 * hi;
              tile_step<64, 1>(lds + (cur ? L_K1 : L_K0), lds + (cur ? L_V1 : L_V0), ko, vo, qf, c, 0.f, tab + (DMAXT - D0), m, l, o); }
            if (i + 1 < ntl) st.store(lds + (cur ? L_K0 : L_K1), lds + (cur ? L_V0 : L_V1));
            __syncthreads();
        }
        l += __shfl_xor(l, 32);
        oa_accum<false>(oap, o, g2 / l, hi);
    }
    { f32x16 acc[2];
#pragma unroll
      for (int db = 0; db < 2; ++db)
#pragma unroll
        for (int g = 0; g < 4; ++g) { const float4 v = *(const float4*)(oap + 32 * db + 8 * g + 4 * hi); acc[db][4 * g] = v.x; acc[db][4 * g + 1] = v.y; acc[db][4 * g + 2] = v.z; acc[db][4 * g + 3] = v.w; }
      store_mixed(p, acc, tok, 64 * h, hi); }
}
constexpr int L_CRED = 0, L_CHID = 16384, CHID_PITCH = 272;
DI void compress_unit(const Params& p, int tid, ALAS char* lds, int layer, int b, int which, int ct) {
    const int lane = tid & 63, w = __builtin_amdgcn_readfirstlane(tid >> 6), r32 = lane & 31, hi = lane >> 5, nb = w & 3, kh = w >> 2;
    const int lw = layer * 2 + which;
    const bf16_t* Prow = (const bf16_t*)(p.ws + WS_P) + ((size_t)b * T + 16 * (32 * ct + r32)) * NP + (which ? C_VCMP : C_KCMP) + 8 * hi;
    const bf16_t* W1 = (const bf16_t*)(p.ws + WS_W1T) + ((size_t)lw * 128 + 32 * nb + r32) * 2048 + 8 * hi;
    f32x16 acc;
#pragma unroll
    for (int r = 0; r < 16; ++r) acc[r] = 0.f;
#pragma unroll 8
    for (int ks = 0; ks < 64; ++ks) { const int kk = kh * 64 + ks;
        const bf16x8 a = *(const bf16x8*)(Prow + (size_t)(kk >> 2) * NP + (kk & 3) * 16);
        const bf16x8 bb = *(const bf16x8*)(W1 + 16 * kk);
        acc = __builtin_amdgcn_mfma_f32_32x32x16_bf16(a, bb, acc, 0, 0, 0); }
    ALAS float* red = (ALAS float*)(lds + L_CRED) + nb * 1024;
    if (kh == 1) {
#pragma unroll
        for (int r = 0; r < 16; ++r) red[((r & 3) + 8 * (r >> 2) + 4 * hi) * 32 + r32] = acc[r];
    }
    __syncthreads();
    if (kh == 0) {
        const float bv = ((const float*)(p.ws + WS_BVEC))[lw * 128 + 32 * nb + r32];
#pragma unroll
        for (int r = 0; r < 16; ++r) { const int c = (r & 3) + 8 * (r >> 2) + 4 * hi; const float a = acc[r] + red[c * 32 + r32] + bv;
            *(ALAS bf16_t*)(lds + L_CHID + c * CHID_PITCH + (32 * nb + r32) * 2) = f2bf(a / (1.f + __expf(-a))); }
    }
    __syncthreads();
    if (w < 2) {
        const bf16_t* W2 = (const bf16_t*)(p.ws + WS_W2T) + ((size_t)lw * 64 + 32 * w + r32) * 128 + 8 * hi;
        f32x16 o;
#pragma unroll
        for (int r = 0; r < 16; ++r) o[r] = 0.f;
#pragma unroll
        for (int ks = 0; ks < 8; ++ks) {
            const bf16x8 a = *(const bf16x8*)(W2 + 16 * ks);
            const bf16x8 hb = *(const ALAS bf16x8*)(lds + L_CHID + r32 * CHID_PITCH + (16 * ks + 8 * hi) * 2);
            o = __builtin_amdgcn_mfma_f32_32x32x16_bf16(a, hb, o, 0, 0, 0); }
        const int c = 32 * ct + r32;
        bf16_t* outp = (bf16_t*)(p.ws + (which ? WS_VC : WS_KC)) + ((size_t)b * 256 + c) * 64 + 32 * w + 4 * hi;
#pragma unroll
        for (int g = 0; g < 4; ++g) { uint2 ow; ow.x = cvtpk(o[4 * g], o[4 * g + 1]); ow.y = cvtpk(o[4 * g + 2], o[4 * g + 3]); if (c == 255) { ow.x = 0u; ow.y = 0u; } *(uint2*)(outp + 8 * g) = ow; }
    }
    __syncthreads();
}
DI void krope_items(const Params& p, int start, int stride) {
    const bf16_t* P = (const bf16_t*)(p.ws + WS_P); bf16_t* Km = (bf16_t*)(p.ws + WS_KM); const float2* rope = (const float2*)(p.ws + WS_ROPE);
    for (int it = start; it < NTOK * 16; it += stride) { const int tok = it >> 4, i = it & 15;
        const float x1 = bf2f(P[(size_t)tok * NP + C_BKR + i]), x2 = bf2f(P[(size_t)tok * NP + C_BKR + 16 + i]); const float2 c2 = rope[(size_t)(tok & (T - 1)) * 16 + i];
        const bf16_t o1 = f2bf(x1 * c2.x - x2 * c2.y), o2 = f2bf(x2 * c2.x + x1 * c2.y);
#pragma unroll
        for (int hh = 0; hh < 4; ++hh) { Km[(size_t)tok * 384 + hh * 96 + 64 + i] = o1; Km[(size_t)tok * 384 + hh * 96 + 80 + i] = o2; } }
}
}

#define XB_TMO      128
#define XB_XCNT(j)  (256  + 64 * (j))
#define XB_XSUB(j)  (1280 + 64 * (j))
#define XB_XGEN(j)  (2304 + 64 * (j))
#define XB_TOP      3328
#define XB_TOPGEN   3392
#define XCD_BAR_WORDS 3456
#define XB_SPIN_CAP (1u << 22)
#define XLAS __attribute__((address_space(3)))
DI unsigned xb_ld(unsigned* p)              { return __hip_atomic_load(p, __ATOMIC_RELAXED, __HIP_MEMORY_SCOPE_AGENT); }
DI unsigned xb_add(unsigned* p, unsigned v) { return __hip_atomic_fetch_add(p, v, __ATOMIC_RELAXED, __HIP_MEMORY_SCOPE_AGENT); }
DI unsigned xb_xcc_id() { return (unsigned)__builtin_amdgcn_s_getreg((3 << 11) | 20) & 0xFu; }
#define XB_SPIN(cond, bar) do { unsigned _sp = 0; while (cond) { __builtin_amdgcn_s_sleep(1); \
    if ((++_sp & 255u) == 0u) { if (xb_ld(&(bar)[XB_TMO])) break; if (_sp > XB_SPIN_CAP) { atomicAdd(&(bar)[XB_TMO], 1u); break; } } } } while (0)
DI void xcd_barrier_complete(unsigned* bar, unsigned x, unsigned& nloc, unsigned& nx) {
    const unsigned G = gridDim.x;
    unsigned sum, cnt, mine, sp = 0u;
    for (;;) {
        sum = 0u; cnt = 0u; mine = 0u;
#pragma unroll
        for (unsigned j = 0; j < 16; ++j) { const unsigned c = xb_ld(&bar[XB_XCNT(j)]); sum += c; cnt += (c > 0u) ? 1u : 0u; mine = (j == x) ? c : mine; }
        if (sum == G) break;
        __builtin_amdgcn_s_sleep(1);
        if ((++sp & 255u) == 0u) { if (xb_ld(&bar[XB_TMO])) break; if (sp > XB_SPIN_CAP) { atomicAdd(&bar[XB_TMO], 1u); break; } }
    }
    nloc = mine > 0u ? mine : 1u; nx = cnt > 0u ? cnt : 1u;
}
DI void xcd_barrier(unsigned* bar, volatile XLAS unsigned* st, bool tid0) {
    asm volatile("s_waitcnt vmcnt(0)" ::: "memory");
    __syncthreads();
    if (tid0) {
        const unsigned x = xb_xcc_id();
        __builtin_amdgcn_s_waitcnt(0);
        unsigned nloc = st[0], nx = st[1];
        if (nloc == 0u) { xcd_barrier_complete(bar, x, nloc, nx); st[0] = nloc; st[1] = nx; }
        const unsigned old = xb_add(&bar[XB_XSUB(x)], 1u);
        const unsigned gen = old / nloc;
        if (old + 1u == (gen + 1u) * nloc) {
            __builtin_amdgcn_fence(__ATOMIC_RELEASE, "agent");
            asm volatile("s_waitcnt vmcnt(0)" ::: "memory");
            const unsigned og = xb_add(&bar[XB_TOP], 1u);
            const unsigned tg = og / nx;
            if (og + 1u == (tg + 1u) * nx) xb_add(&bar[XB_TOPGEN], 1u);
            else XB_SPIN(xb_ld(&bar[XB_TOPGEN]) == tg, bar);
            __builtin_amdgcn_fence(__ATOMIC_ACQUIRE, "agent");
            xb_add(&bar[XB_XGEN(x)], 1u);
            asm volatile("s_waitcnt vmcnt(0)" ::: "memory");
        } else {
            XB_SPIN(xb_ld(&bar[XB_XGEN(x)]) == gen, bar);
            __builtin_amdgcn_fence(__ATOMIC_ACQUIRE, "agent");
            asm volatile("s_waitcnt vmcnt(0)" ::: "memory");
        }
    }
    __syncthreads();
}

constexpr int SMEM_BYTES = 160 * 1024;
constexpr int PARAM_OFF = SMEM_BYTES - 256;
constexpr int VSMEM = 49152;

__global__ void __launch_bounds__(512, 2) mega(Params p0) {
    extern __shared__ __attribute__((aligned(16))) char smem[];
    cg::grid_group grid = cg::this_grid();
    if (threadIdx.x == 0) {
        ALAS unsigned long long* pl = (ALAS unsigned long long*)((ALAS char*)smem + PARAM_OFF);
#pragma unroll
        for (int i_ = 0; i_ < 14; ++i_) pl[i_] = (unsigned long long)p0.in[i_];
        pl[14] = (unsigned long long)p0.xout; pl[15] = (unsigned long long)p0.ws;
    }
    if (threadIdx.x == 0) {
        volatile XLAS unsigned* st0 = (volatile XLAS unsigned*)((XLAS char*)smem + PARAM_OFF + 128); st0[0] = 0u; st0[1] = 0u;
        (void)xb_add(&((unsigned*)(p0.ws + WS_BAR))[XB_XCNT(xb_xcc_id())], 1u);
    }
    __syncthreads();
    const int wid_s = __builtin_amdgcn_readfirstlane((int)(threadIdx.x >> 6));
#ifndef PROBE_REP_K
#define PROBE_REP_K -2
#endif
#ifndef PROBE_SYNC
#define PROBE_SYNC 0
#endif
    constexpr int NSTEP = 5 + (PROBE_REP_K >= 0 ? 1 : 0);
    for (int ph = 0; ph < 1 + NSTEP * DEPTH; ++ph) {
        int ph_ = ph; asm volatile("" : "+s"(ph_));
#define MKTID(dst) do { int w__ = wid_s; unsigned ones__ = ~0u; asm volatile("" : "+s"(w__), "+s"(ones__)); \
        (dst) = w__ * 64 + (int)__builtin_amdgcn_mbcnt_hi(ones__, __builtin_amdgcn_mbcnt_lo(ones__, 0u)); } while (0)
        Params p;
        {
            unsigned poff_ = PARAM_OFF; asm volatile("" : "+v"(poff_));
            const ALAS unsigned* pl = (const ALAS unsigned*)((ALAS char*)smem + poff_);
#pragma unroll
            for (int i_ = 0; i_ < 16; ++i_) {
                const unsigned lo_ = (unsigned)__builtin_amdgcn_readfirstlane((int)pl[2 * i_]), hi_ = (unsigned)__builtin_amdgcn_readfirstlane((int)pl[2 * i_ + 1]);
                const unsigned long long v_ = ((unsigned long long)hi_ << 32) | lo_;
                if (i_ < 14) p.in[i_] = (const float*)v_; else if (i_ == 14) p.xout = (float*)v_; else p.ws = (char*)v_;
            }
        }
        int G = gridDim.x, bid = blockIdx.x; asm volatile("" : "+s"(G), "+s"(bid));
        const int NGW = G * 8;
        const int l = (ph_ - 1) / NSTEP, j_ = (ph_ - 1) % NSTEP, k = ph_ == 0 ? -1 : ((PROBE_REP_K >= 0 && j_ > PROBE_REP_K) ? j_ - 1 : j_);
        if (k == -1) {
            int t_; MKTID(t_);
            pro_all(p, bid * 512 + t_, G * 512);
            pro_weights(p, bid, G, t_, smem);
            for (int row = bid * 8 + (t_ >> 6); row < NTOK; row += NGW) pro_xrow(p, row, t_ & 63);
        } else if (k == 0) {
            int t_; MKTID(t_);
            pg8::Gemm g{((bf16_t*)(p.ws + WS_XB)), ((bf16_t*)(p.ws + WS_WTIN)) + (size_t)l * NP * D, NTOK, NP, D, D};
            pg8::StaticOrder S; S.init(NTOK, NP, G, bid);
            pg8::EpiInProj E{((bf16_t*)(p.ws + WS_P)), ((float*)(p.ws + WS_RS)), ((float*)(p.ws + WS_SSQQ)), ((float*)(p.ws + WS_SSQKV))};
            pg8::gemm_phase<pg8::EpiInProj, pg8::StaticOrder, true, true>(t_, (PG8_LAS unsigned char*)smem, g, S, E);
        } else if (k == 1) {
            int t_; MKTID(t_);
            const int G2 = G >> 1;
            if (bid < G2) {
                pg8::Gemm g{(const bf16_t*)(p.ws + WS_P) + C_BCQ, (const bf16_t*)(p.ws + WS_WUQ) + (size_t)l * 512 * 256, NTOK, 512, 256, NP};
                pg8::StaticOrder S; S.init(NTOK, 512, G2, bid);
                pg8::EpiQ E{(bf16_t*)(p.ws + WS_QM), (const float*)(p.ws + WS_SSQQ), (const float2*)(p.ws + WS_ROPE)};
                pg8::gemm_phase<pg8::EpiQ, pg8::StaticOrder, true, true>(t_, (PG8_LAS unsigned char*)smem, g, S, E);
            } else {
                { pg8::Gemm g{(const bf16_t*)(p.ws + WS_P) + C_BCKV, (const bf16_t*)(p.ws + WS_WUKV) + (size_t)l * 512 * 128, NTOK, 512, 128, NP};
                  pg8::StaticOrder S; S.init(NTOK, 512, G - G2, bid - G2);
                  pg8::EpiKV E{(bf16_t*)(p.ws + WS_KM), (bf16_t*)(p.ws + WS_VM), (const float*)(p.ws + WS_SSQKV)};
                  pg8::gemm_phase<pg8::EpiKV, pg8::StaticOrder, true, true>(t_, (PG8_LAS unsigned char*)smem, g, S, E); }
                __syncthreads();
                for (int u = bid - G2; u < 64; u += G - G2) { int tt; MKTID(tt); att::compress_unit(p, tt, (ALAS char*)smem, l, u >> 4, (u >> 3) & 1, u & 7); }
                { int tk; MKTID(tk); att::krope_items(p, (bid - G2) * 512 + tk, (G - G2) * 512); }
            }
        } else if (k == 2) {
            ALAS char* L = (ALAS char*)smem;
            { int tb; MKTID(tb); att::build_table((ALAS float*)(L + att::L_TAB), nullptr, 1 << 30, tb, 512); }
            __syncthreads();
            for (int u = bid; u < 256; u += G) { const int qt = 15 - (u >> 4), bh = u & 15; int tt; MKTID(tt); att::mla_unit(p, tt, L, bh >> 2, bh & 3, qt); }
            __syncthreads();
            { int tb; MKTID(tb); att::nsa_tables(p, tb, L); }
            __syncthreads();
            for (int u = bid; u < 256; u += G) { int tt; MKTID(tt); att::nsa_unit(p, tt, L, u & 3, u >> 2); }
            __syncthreads();
            { int tb; MKTID(tb); for (int hh = 0; hh < 8; ++hh) att::build_table((ALAS float*)(L + att::L_TAB) + hh * att::TABN, (const float*)(p.ws + WS_BTAB) + (4 + hh) * BT_STRIDE, 128, tb, 512); }
            __syncthreads();
            for (int u = bid; u < 512; u += G) { int tt; MKTID(tt); att::swa_unit(p, tt, L, l, u & 3, u >> 2); }
        } else if (k == 3) {
            int t_; MKTID(t_);
            pg8::Gemm g{((bf16_t*)(p.ws + WS_MIX)), ((bf16_t*)(p.ws + WS_WTOUT)) + (size_t)l * D * D, NTOK, D, D, D};
            pg8::StaticOrder S; S.init(NTOK, D, G, bid);
            pg8::EpiF32 E{((float*)(p.ws + WS_P)), D};
            pg8::gemm_phase<pg8::EpiF32, pg8::StaticOrder, true, true>(t_, (PG8_LAS unsigned char*)smem, g, S, E);
        } else {
            int t_; MKTID(t_);
            for (int row = bid * 8 + (t_ >> 6); row < NTOK; row += NGW) post_row(p, l, row, t_ & 63);
        }
        if (ph_ == 0) grid.sync();
        else { int tb_; MKTID(tb_); xcd_barrier((unsigned*)(p.ws + WS_BAR), (volatile XLAS unsigned*)((XLAS char*)smem + PARAM_OFF + 128), tb_ == 0); }
        for (int e_ = 0; e_ < PROBE_SYNC; ++e_) { int tb_; MKTID(tb_); xcd_barrier((unsigned*)(p.ws + WS_BAR), (volatile XLAS unsigned*)((XLAS char*)smem + PARAM_OFF + 128), tb_ == 0); }
    }
}

extern "C" void kernel_launch(void* const* d_in, const int* in_sizes, int n_in, void* d_out, int out_size, void* d_ws, size_t ws_size, hipStream_t stream) {
    Params p{};
    for (int i = 0; i < 14; ++i) p.in[i] = (const float*)d_in[i];
    p.xout = (float*)d_out; p.ws = (char*)d_ws;
    const size_t off = WS_END;
    static int grid_blocks = 0;
    if (!grid_blocks) {
        int dev = 0, cus = 0, per_cu = 0;
        (void)hipGetDevice(&dev);
        (void)hipDeviceGetAttribute(&cus, hipDeviceAttributeMultiprocessorCount, dev);
        (void)hipFuncSetAttribute((const void*)mega, hipFuncAttributeMaxDynamicSharedMemorySize, SMEM_BYTES);
        (void)hipOccupancyMaxActiveBlocksPerMultiprocessor(&per_cu, (const void*)mega, 512, SMEM_BYTES);
        if (per_cu < 1) fprintf(stderr, "occupancy query says %d blocks per CU\n", per_cu);
        grid_blocks = cus;
        if (off > ws_size) fprintf(stderr, "workspace too small: need %zu have %zu\n", off, ws_size);
    }
    (void)hipMemsetAsync((char*)d_ws + WS_BAR, 0, XCD_BAR_WORDS * 4, stream);
    void* args[] = {&p};
    hipError_t e = hipLaunchCooperativeKernel((void*)mega, dim3(grid_blocks), dim3(512), args, SMEM_BYTES, stream);
    if (e != hipSuccess) fprintf(stderr, "cooperative launch failed: %s (grid %d)\n", hipGetErrorString(e), grid_blocks);
}
```
